# Optimizing an MI355X kernel written in HIP

```python
import math
import jax, jax.numpy as jnp
from jax import lax
import numpy as np

D_MODEL = 1024
BATCH = 4
SEQ = 4096
DEPTH = 2

NORM_EPS = 1e-6
D_FF = 4 * D_MODEL
QBLK = 128
NEG_INF = -1e30
FORCE_SCORE = 1e4

NUM_BUCKETS = 32
MAX_DISTANCE = 1024

LRU_WIDTH = D_MODEL // 2
LRU_BLOCKS = 8
LRU_BLOCK_DIM = LRU_WIDTH // LRU_BLOCKS
CONV_WIDTH = 4
LRU_C = 8.0

MLA_HEADS = 8
MLA_NOPE = 64
MLA_ROPE = 32
MLA_QK = MLA_NOPE + MLA_ROPE
MLA_V = 64
MLA_Q_RANK = 384
MLA_KV_RANK = 256
ROPE_THETA = 10000.0

HY_SPLITS = (LRU_WIDTH, LRU_WIDTH, MLA_Q_RANK, MLA_KV_RANK, MLA_ROPE)
HY_IN = sum(HY_SPLITS)
HY_OUT = LRU_WIDTH + MLA_HEADS * MLA_V

NSA_HEADS = 16
NSA_GROUPS = 2
NSA_HPG = NSA_HEADS // NSA_GROUPS
NSA_DK = 64
NSA_DV = 64
NSA_KV = NSA_GROUPS * NSA_DK
CMP_BLOCK = 32
CMP_STRIDE = 16
CMP_HIDDEN = 256
SLC_BLOCK = 64
SLC_TOPN = 8
WINDOW = 512
NSA_SPLITS = (NSA_HEADS * NSA_DK,) + (NSA_KV,) * 6 + (3 * NSA_HEADS,)
NSA_IN = sum(NSA_SPLITS)
NSA_OUT = NSA_HEADS * NSA_DV

N_EVEN = (DEPTH + 1) // 2
N_ODD = DEPTH // 2

kernel_name = 'hybrid_rglru_mla_nsa_trunk'


def rms_norm(x, g):
    xf = x.astype(jnp.float32)
    y = xf * lax.rsqrt(jnp.mean(xf * xf, axis=-1, keepdims=True) + NORM_EPS)
    return (y * g.astype(jnp.float32)).astype(x.dtype)


def split_cols(z, sizes):
    out, off = [], 0
    for s in sizes:
        out.append(z[..., off:off + s])
        off += s
    return out


def t5_bucket(dist):
    n = jnp.maximum(dist, 0)
    max_exact = NUM_BUCKETS // 2
    nf = jnp.maximum(n, 1).astype(jnp.float32)
    large = max_exact + (jnp.log(nf / max_exact) / math.log(MAX_DISTANCE / max_exact)
                         * (NUM_BUCKETS - max_exact)).astype(jnp.int32)
    large = jnp.minimum(large, NUM_BUCKETS - 1)
    return jnp.where(n < max_exact, n, large)


def apply_rope(x, pos):
    half = x.shape[-1] // 2
    freqs = ROPE_THETA ** (-jnp.arange(half, dtype=jnp.float32) / half)
    ang = pos.astype(jnp.float32)[:, None] * freqs[None, :]
    cos = jnp.cos(ang)[None, :, None, :]
    sin = jnp.sin(ang)[None, :, None, :]
    xf = x.astype(jnp.float32)
    x1, x2 = xf[..., :half], xf[..., half:]
    return jnp.concatenate([x1 * cos - x2 * sin, x2 * cos + x1 * sin], axis=-1).astype(x.dtype)


def causal_depthwise_conv(x, w, b):
    S = x.shape[1]
    xp = jnp.pad(x, ((0, 0), (CONV_WIDTH - 1, 0), (0, 0)))
    y = xp[:, 0:S] * w[0]
    for k in range(1, CONV_WIDTH):
        y = y + xp[:, k:k + S] * w[k]
    return y + b


def rg_lru(x, wa, ba, wx, bx, lam):
    B, S, C = x.shape
    xb = x.reshape(B, S, LRU_BLOCKS, LRU_BLOCK_DIM)
    r = jax.nn.sigmoid(jnp.einsum('bsnd,nde->bsne', xb, wa) + ba).reshape(B, S, C)
    i = jax.nn.sigmoid(jnp.einsum('bsnd,nde->bsne', xb, wx) + bx).reshape(B, S, C)
    log_a = -LRU_C * r.astype(jnp.float32) * jax.nn.softplus(-lam.astype(jnp.float32))
    a = jnp.exp(log_a)
    mult = jnp.sqrt(-jnp.expm1(2.0 * log_a))
    mult = mult.at[:, 0].set(1.0)
    b_in = mult * (i * x).astype(jnp.float32)

    def combine(lhs, rhs):
        a1, b1 = lhs
        a2, b2 = rhs
        return a1 * a2, a2 * b1 + b2

    _, h = lax.associative_scan(combine, (a, b_in), axis=1)
    return h.astype(x.dtype)


def causal_block_attention(q, k, v):
    B, H, S, dk = q.shape
    dv = v.shape[-1]
    nb = S // QBLK
    scale = dk ** -0.5
    qb = q.reshape(B, H, nb, QBLK, dk).transpose(2, 0, 1, 3, 4)
    kpos = jnp.arange(S)

    def body(args):
        qi, blk = args
        qpos = blk * QBLK + jnp.arange(QBLK)
        s = jnp.einsum('bhqd,bhkd->bhqk', qi, k).astype(jnp.float32) * scale
        s = jnp.where(kpos[None, :] <= qpos[:, None], s, NEG_INF)
        p = jax.nn.softmax(s, axis=-1).astype(v.dtype)
        return jnp.einsum('bhqk,bhkd->bhqd', p, v)

    o = lax.map(body, (qb, jnp.arange(nb)))
    return o.transpose(1, 0, 3, 2, 4).reshape(B, S, H * dv)


def hybrid_mixer(u, w_in, conv_w, conv_b, wa, ba, wx, bx, lam,
                 q_norm, kv_norm, w_uq, w_ukv, qn_q, qn_k, w_out):
    B, S, _ = u.shape
    pos = jnp.arange(S)
    z = u @ w_in
    xr, xg, q_lat, kv_lat, k_rope = split_cols(z, HY_SPLITS)
    lru = rg_lru(causal_depthwise_conv(xr, conv_w, conv_b), wa, ba, wx, bx, lam)
    lru = lru * jax.nn.gelu(xg)
    q = (rms_norm(q_lat, q_norm) @ w_uq).reshape(B, S, MLA_HEADS, MLA_QK)
    kv = (rms_norm(kv_lat, kv_norm) @ w_ukv).reshape(B, S, MLA_HEADS, MLA_NOPE + MLA_V)
    k_nope, v = kv[..., :MLA_NOPE], kv[..., MLA_NOPE:]
    k_r = jnp.broadcast_to(k_rope[:, :, None, :], (B, S, MLA_HEADS, MLA_ROPE))
    k = jnp.concatenate([k_nope, k_r], axis=-1)
    q = rms_norm(q, qn_q)
    k = rms_norm(k, qn_k)
    q = jnp.concatenate([q[..., :MLA_NOPE], apply_rope(q[..., MLA_NOPE:], pos)], axis=-1)
    k = jnp.concatenate([k[..., :MLA_NOPE], apply_rope(k[..., MLA_NOPE:], pos)], axis=-1)
    mla = causal_block_attention(q.transpose(0, 2, 1, 3), k.transpose(0, 2, 1, 3),
                                 v.transpose(0, 2, 1, 3))
    return jnp.concatenate([lru, mla], axis=-1) @ w_out


def nsa_mixer(u, w_in, pos_k, w1_k, w2_k, pos_v, w1_v, w2_v, q_norm, k_norm, rel_bias, w_out):
    B, S, _ = u.shape
    G, HPG, DK, DV = NSA_GROUPS, NSA_HPG, NSA_DK, NSA_DV
    z = u @ w_in
    q, kc, vc, ks, vs, kw, vw, gate = split_cols(z, NSA_SPLITS)
    q = rms_norm(q.reshape(B, S, NSA_HEADS, DK), q_norm).reshape(B, S, G, HPG, DK)
    gate = jax.nn.sigmoid(gate).reshape(B, S, NSA_HEADS, 3)

    nc = (S - CMP_BLOCK) // CMP_STRIDE + 1
    cstart = jnp.arange(nc) * CMP_STRIDE
    cend = cstart + CMP_BLOCK - 1
    cidx = cstart[:, None] + jnp.arange(CMP_BLOCK)[None, :]

    def compress(t, pos_emb, w1, w2):
        t = t.reshape(B, S, G, DK)[:, cidx]
        t = t + pos_emb[None, None, :, None, :]
        t = t.transpose(0, 1, 3, 2, 4).reshape(B, nc, G, CMP_BLOCK * DK)
        return jax.nn.gelu(t @ w1) @ w2

    ck = rms_norm(compress(kc, pos_k, w1_k, w2_k), k_norm[0])
    cv = compress(vc, pos_v, w1_v, w2_v)

    nsel = S // SLC_BLOCK
    n_top = min(SLC_TOPN, nsel)
    kb = rms_norm(ks.reshape(B, S, G, DK), k_norm[1]).reshape(B, nsel, SLC_BLOCK, G, DK).transpose(0, 3, 1, 2, 4)
    vb = vs.reshape(B, nsel, SLC_BLOCK, G, DV).transpose(0, 3, 1, 2, 4)
    sstart = jnp.arange(nsel) * SLC_BLOCK
    ov = jnp.clip(jnp.minimum(cstart[:, None] + CMP_BLOCK, sstart[None, :] + SLC_BLOCK)
                  - jnp.maximum(cstart[:, None], sstart[None, :]), 0, None).astype(jnp.float32) / CMP_BLOCK

    kw_pad = jnp.pad(rms_norm(kw.reshape(B, S, G, DK), k_norm[2]), ((0, 0), (WINDOW, 0), (0, 0), (0, 0)))
    vw_pad = jnp.pad(vw.reshape(B, S, G, DV), ((0, 0), (WINDOW, 0), (0, 0), (0, 0)))

    tab = rel_bias.reshape(NUM_BUCKETS, G, HPG)
    tab_g = tab.transpose(1, 0, 2)
    scale = DK ** -0.5
    nb = S // QBLK
    qb = q.reshape(B, nb, QBLK, G, HPG, DK).transpose(1, 0, 2, 3, 4, 5)
    bi = jnp.arange(B)[:, None, None, None]
    gi = jnp.arange(G)[None, :, None, None]
    blk_id = jnp.arange(nsel)

    def block(args):
        qi, blk = args
        q0 = blk * QBLK
        qpos = q0 + jnp.arange(QBLK)
        s = jnp.einsum('bqghd,bngd->bghqn', qi, ck).astype(jnp.float32) * scale
        s = s + tab[t5_bucket(qpos[:, None] - cend[None, :])].transpose(2, 3, 0, 1)
        valid_c = cend[None, :] <= qpos[:, None]
        s = jnp.where(valid_c, s, NEG_INF)
        p_c = jax.nn.softmax(s, axis=-1) * jnp.any(valid_c, axis=-1)[:, None]
        o_c = jnp.einsum('bghqn,bngd->bqghd', p_c.astype(cv.dtype), cv)
        imp = jnp.einsum('bghqn,nm->bgqm', p_c, ov)
        cur = qpos // SLC_BLOCK
        valid_s = sstart[None, :] <= qpos[:, None]
        forced = (blk_id[None, :] == 0) | (blk_id[None, :] == cur[:, None]) | (blk_id[None, :] == cur[:, None] - 1)
        score = jnp.where(valid_s & forced, FORCE_SCORE, jnp.where(valid_s, imp, -1.0))
        _, idx = lax.top_k(score, n_top)
        k_sel = kb[bi, gi, idx].reshape(B, G, QBLK, n_top * SLC_BLOCK, DK)
        v_sel = vb[bi, gi, idx].reshape(B, G, QBLK, n_top * SLC_BLOCK, DV)
        kpos = (idx[..., None] * SLC_BLOCK + jnp.arange(SLC_BLOCK)).reshape(B, G, QBLK, n_top * SLC_BLOCK)
        dist = qpos[None, None, :, None] - kpos
        s = jnp.einsum('bqghd,bgqkd->bghqk', qi, k_sel).astype(jnp.float32) * scale
        s = s + tab_g[gi, t5_bucket(dist)].transpose(0, 1, 4, 2, 3)
        s = jnp.where((dist >= 0)[:, :, None], s, NEG_INF)
        p_s = jax.nn.softmax(s, axis=-1).astype(v_sel.dtype)
        o_s = jnp.einsum('bghqk,bgqkd->bqghd', p_s, v_sel)
        k_win = lax.dynamic_slice_in_dim(kw_pad, q0, WINDOW + QBLK, axis=1)
        v_win = lax.dynamic_slice_in_dim(vw_pad, q0, WINDOW + QBLK, axis=1)
        wpos = q0 - WINDOW + jnp.arange(WINDOW + QBLK)
        wdist = qpos[:, None] - wpos[None, :]
        wmask = (wdist >= 0) & (wdist < WINDOW) & (wpos[None, :] >= 0)
        s = jnp.einsum('bqghd,bkgd->bghqk', qi, k_win).astype(jnp.float32) * scale
        s = s + tab[t5_bucket(wdist)].transpose(2, 3, 0, 1)
        s = jnp.where(wmask, s, NEG_INF)
        p_w = jax.nn.softmax(s, axis=-1).astype(v_win.dtype)
        o_w = jnp.einsum('bghqk,bkgd->bqghd', p_w, v_win)
        return o_c, o_s, o_w

    o_c, o_s, o_w = lax.map(block, (qb, jnp.arange(nb)))

    def unblock(o):
        return o.transpose(1, 0, 2, 3, 4, 5).reshape(B, S, NSA_HEADS, DV)

    o = (gate[..., 0:1] * unblock(o_c) + gate[..., 1:2] * unblock(o_s)
         + gate[..., 2:3] * unblock(o_w))
    return o.reshape(B, S, NSA_OUT) @ w_out


def squared_relu_mlp(u, w1, w2):
    return jnp.square(jax.nn.relu(u @ w1)) @ w2


def setup_inputs(seed: int = 0) -> dict:
    key = jax.random.key(seed)
    keys = iter(jax.random.split(key, 40))
    f32 = jnp.float32

    def nrm(shape, fan_in):
        return jax.random.normal(next(keys), shape, f32) * fan_in ** -0.5

    def gain(shape):
        return 1.0 + 0.05 * jax.random.normal(next(keys), shape, f32)

    def small(shape, s=0.1):
        return s * jax.random.normal(next(keys), shape, f32)

    x = jax.random.normal(next(keys), (BATCH, SEQ, D_MODEL), f32)
    rel_bias = small((NUM_BUCKETS, NSA_HEADS), 0.5)
    norm_mix = gain((DEPTH, D_MODEL))
    norm_mlp = gain((DEPTH, D_MODEL))
    mlp_w1 = nrm((DEPTH, D_MODEL, D_FF), D_MODEL)
    mlp_w2 = nrm((DEPTH, D_FF, D_MODEL), D_FF)
    hy_w_in = nrm((N_EVEN, D_MODEL, HY_IN), D_MODEL)
    lru_conv_w = nrm((N_EVEN, CONV_WIDTH, LRU_WIDTH), CONV_WIDTH)
    lru_conv_b = small((N_EVEN, LRU_WIDTH))
    lru_wa = nrm((N_EVEN, LRU_BLOCKS, LRU_BLOCK_DIM, LRU_BLOCK_DIM), LRU_BLOCK_DIM)
    lru_ba = small((N_EVEN, LRU_BLOCKS, LRU_BLOCK_DIM))
    lru_wx = nrm((N_EVEN, LRU_BLOCKS, LRU_BLOCK_DIM, LRU_BLOCK_DIM), LRU_BLOCK_DIM)
    lru_bx = small((N_EVEN, LRU_BLOCKS, LRU_BLOCK_DIM))
    a_c = jax.random.uniform(next(keys), (N_EVEN, LRU_WIDTH), f32, minval=0.9, maxval=0.999)
    a0 = a_c ** (1.0 / LRU_C)
    lru_lambda = jnp.log(a0 / (1.0 - a0))
    mla_q_norm = gain((N_EVEN, MLA_Q_RANK))
    mla_kv_norm = gain((N_EVEN, MLA_KV_RANK))
    mla_w_uq = nrm((N_EVEN, MLA_Q_RANK, MLA_HEADS * MLA_QK), MLA_Q_RANK)
    mla_w_ukv = nrm((N_EVEN, MLA_KV_RANK, MLA_HEADS * (MLA_NOPE + MLA_V)), MLA_KV_RANK)
    mla_qn_q = gain((N_EVEN, MLA_QK))
    mla_qn_k = gain((N_EVEN, MLA_QK))
    hy_w_out = nrm((N_EVEN, HY_OUT, D_MODEL), HY_OUT)
    nsa_w_in = nrm((N_ODD, D_MODEL, NSA_IN), D_MODEL)
    nsa_cmp_pos_k = small((N_ODD, CMP_BLOCK, NSA_DK))
    nsa_cmp_w1_k = nrm((N_ODD, CMP_BLOCK * NSA_DK, CMP_HIDDEN), CMP_BLOCK * NSA_DK)
    nsa_cmp_w2_k = nrm((N_ODD, CMP_HIDDEN, NSA_DK), CMP_HIDDEN)
    nsa_cmp_pos_v = small((N_ODD, CMP_BLOCK, NSA_DV))
    nsa_cmp_w1_v = nrm((N_ODD, CMP_BLOCK * NSA_DV, CMP_HIDDEN), CMP_BLOCK * NSA_DV)
    nsa_cmp_w2_v = nrm((N_ODD, CMP_HIDDEN, NSA_DV), CMP_HIDDEN)
    nsa_q_norm = gain((N_ODD, NSA_DK))
    nsa_k_norm = gain((N_ODD, 3, NSA_DK))
    nsa_w_out = nrm((N_ODD, NSA_OUT, D_MODEL), NSA_OUT)
    return {'x': x, 'rel_bias': rel_bias, 'norm_mix': norm_mix, 'norm_mlp': norm_mlp,
            'mlp_w1': mlp_w1, 'mlp_w2': mlp_w2, 'hy_w_in': hy_w_in,
            'lru_conv_w': lru_conv_w, 'lru_conv_b': lru_conv_b, 'lru_wa': lru_wa, 'lru_ba': lru_ba,
            'lru_wx': lru_wx, 'lru_bx': lru_bx, 'lru_lambda': lru_lambda,
            'mla_q_norm': mla_q_norm, 'mla_kv_norm': mla_kv_norm, 'mla_w_uq': mla_w_uq,
            'mla_w_ukv': mla_w_ukv, 'mla_qn_q': mla_qn_q, 'mla_qn_k': mla_qn_k, 'hy_w_out': hy_w_out,
            'nsa_w_in': nsa_w_in, 'nsa_cmp_pos_k': nsa_cmp_pos_k, 'nsa_cmp_w1_k': nsa_cmp_w1_k,
            'nsa_cmp_w2_k': nsa_cmp_w2_k, 'nsa_cmp_pos_v': nsa_cmp_pos_v, 'nsa_cmp_w1_v': nsa_cmp_w1_v,
            'nsa_cmp_w2_v': nsa_cmp_w2_v, 'nsa_q_norm': nsa_q_norm, 'nsa_k_norm': nsa_k_norm,
            'nsa_w_out': nsa_w_out}


def reference(x, rel_bias, norm_mix, norm_mlp, mlp_w1, mlp_w2, hy_w_in,
              lru_conv_w, lru_conv_b, lru_wa, lru_ba, lru_wx, lru_bx, lru_lambda,
              mla_q_norm, mla_kv_norm, mla_w_uq, mla_w_ukv, mla_qn_q, mla_qn_k, hy_w_out,
              nsa_w_in, nsa_cmp_pos_k, nsa_cmp_w1_k, nsa_cmp_w2_k, nsa_cmp_pos_v, nsa_cmp_w1_v,
              nsa_cmp_w2_v, nsa_q_norm, nsa_k_norm, nsa_w_out):
    h = x
    for layer in range(DEPTH):
        u = rms_norm(h, norm_mix[layer])
        if layer % 2 == 0:
            e = layer // 2
            mix = hybrid_mixer(u, hy_w_in[e], lru_conv_w[e], lru_conv_b[e], lru_wa[e], lru_ba[e],
                               lru_wx[e], lru_bx[e], lru_lambda[e], mla_q_norm[e], mla_kv_norm[e],
                               mla_w_uq[e], mla_w_ukv[e], mla_qn_q[e], mla_qn_k[e], hy_w_out[e])
        else:
            o = layer // 2
            mix = nsa_mixer(u, nsa_w_in[o], nsa_cmp_pos_k[o], nsa_cmp_w1_k[o], nsa_cmp_w2_k[o],
                            nsa_cmp_pos_v[o], nsa_cmp_w1_v[o], nsa_cmp_w2_v[o], nsa_q_norm[o],
                            nsa_k_norm[o], rel_bias, nsa_w_out[o])
        h = h + mix
        h = h + squared_relu_mlp(rms_norm(h, norm_mlp[layer]), mlp_w1[layer], mlp_w2[layer])
    return h
```

```cpp
#ifndef CPU_EMU
#include <hip/hip_runtime.h>
#include <hip/hip_cooperative_groups.h>
#include <cstdio>
#include <cstdint>
#define DEVFN __device__ __forceinline__
#define HDFN __host__ __device__ __forceinline__
#define MEMFN __device__ __forceinline__
#else
#define DEVFN static inline
#define HDFN static inline
#define MEMFN inline
#endif
#include <cmath>

#ifndef BATCH
#define BATCH 4
#endif
#ifndef SEQ
#define SEQ 4096
#endif

typedef unsigned short bf16_t;
typedef float f32x4 __attribute__((ext_vector_type(4)));

constexpr int B_ = BATCH, S_ = SEQ, T_ = B_ * S_, D_ = 1024, FF_ = 4096;
constexpr int HYIN = 1696, HYIN_P = 1792, NSAIN = 1840, NSAIN_P = 2048;
constexpr int NC_ = (S_ - 32) / 16 + 1, NCP_ = S_ / 16, NSEL_ = S_ / 64, NCH_ = S_ / 64;
constexpr int MCMP = B_ * 2 * NCP_;
constexpr float EPS_ = 1e-6f;

constexpr size_t MiB = 1u << 20;
constexpr size_t OFF_CTL = 0;
constexpr size_t OFF_BOUND = 32 * 1024;
constexpr size_t OFF_BKT = 44 * 1024;
constexpr size_t OFF_PTRS = 40 * 1024;
constexpr size_t OFF_ROPE = 256 * 1024;
constexpr size_t OFF_CBIAS = 64 * 1024;
constexpr size_t OFF_SSQ = 1 * MiB;
constexpr size_t OFF_W = OFF_SSQ + (size_t)T_ * 64;
constexpr size_t W_HYIN = OFF_W;
constexpr size_t W_UQ = W_HYIN + (size_t)HYIN_P * 1024 * 2;
constexpr size_t W_UKV = W_UQ + (size_t)768 * 384 * 2;
constexpr size_t W_HYOUT = W_UKV + (size_t)1024 * 256 * 2;
constexpr size_t W_MLP1 = W_HYOUT + (size_t)1024 * 1024 * 2;
constexpr size_t W_MLP2 = W_MLP1 + (size_t)2 * 4096 * 1024 * 2;
constexpr size_t W_NSAIN = W_MLP2 + (size_t)2 * 4096 * 1024 * 2;
constexpr size_t W_C1K = W_NSAIN + (size_t)NSAIN_P * 1024 * 2;
constexpr size_t W_C1V = W_C1K + (size_t)256 * 2048 * 2;
constexpr size_t W_NSAOUT = W_C1V + (size_t)256 * 2048 * 2;
constexpr size_t W_GATE = W_NSAOUT + (size_t)1024 * 1024 * 2;
constexpr size_t OFF_XN = W_GATE + (size_t)1024 * 512 * 2;
constexpr size_t OFF_BIG = OFF_XN + (size_t)T_ * 2048;
constexpr size_t OFF_SM = OFF_BIG + (size_t)T_ * 8192;
#ifdef CPU_EMU
constexpr size_t OFF_QN = OFF_XN;
#else
constexpr size_t OFF_QN = OFF_BIG + (size_t)T_ * 6144;
#endif
constexpr size_t SM_KROPE = OFF_SM;
constexpr size_t SM_CAT = SM_KROPE + (size_t)T_ * 128;
constexpr size_t SM_SCAN = SM_CAT + (size_t)T_ * 2048;
constexpr size_t SM_L0_END = SM_SCAN + (size_t)2 * B_ * NCH_ * 512 * 4;
constexpr size_t SM_KV = OFF_SM;
constexpr size_t KVSZ = (size_t)T_ * 128 * 2;
constexpr size_t SM_GATE = SM_KV + 6 * KVSZ + 4096;
constexpr size_t SM_HK = SM_GATE + (size_t)T_ * 192;
constexpr size_t SM_HV = SM_HK + (size_t)MCMP * 512;
constexpr size_t SM_CK = SM_HV + (size_t)MCMP * 512;
constexpr size_t SM_CV = SM_CK + (size_t)MCMP * 128;
constexpr size_t SM_STAT = SM_CV + (size_t)MCMP * 128;
constexpr size_t SM_IMP = SM_STAT + (size_t)T_ * 128;
constexpr size_t SM_IDX = SM_IMP + (size_t)T_ * 2 * NSEL_ * 4;
constexpr size_t SM_L1_END = SM_IDX + (size_t)T_ * 64;
constexpr size_t WS_NEED = SM_L0_END > SM_L1_END ? SM_L0_END : SM_L1_END;
constexpr size_t DO_K0 = 0;
constexpr size_t DO_V0 = DO_K0 + (size_t)T_ * 8 * 96 * 2;
constexpr size_t DO_QLAT = DO_V0 + (size_t)T_ * 8 * 64 * 2;
constexpr size_t DO_KVLAT = DO_QLAT + (size_t)T_ * 384 * 2;
static_assert(DO_KVLAT + (size_t)T_ * 256 * 2 <= (size_t)T_ * 4096, "d_out scratch");
#if BATCH == 4 && SEQ == 4096
static_assert(WS_NEED <= 256 * MiB, "workspace map exceeds 256 MiB");
#endif

struct Params { const float* in[31]; float* out; unsigned char* ws; };
enum { I_X = 0, I_RELB, I_NMIX, I_NMLP, I_W1, I_W2, I_HYIN, I_CONVW, I_CONVB, I_WA, I_BA, I_WX, I_BX, I_LAM, I_QNORM, I_KVNORM, I_WUQ, I_WUKV,
       I_QNQ, I_QNK, I_HYOUT, I_NSAIN, I_POSK, I_C1K, I_C2K, I_POSV, I_C1V, I_C2V, I_NQN, I_NKN, I_NSAOUT };

DEVFN unsigned f2u(float f) { return __builtin_bit_cast(unsigned, f); }
DEVFN float u2f(unsigned u) { return __builtin_bit_cast(float, u); }
DEVFN bf16_t f2bf(float f) { unsigned u = f2u(f); return (bf16_t)((u + 0x7fffu + ((u >> 16) & 1u)) >> 16); }
DEVFN float bf2f(bf16_t h) { return u2f((unsigned)h << 16); }
DEVFN float sigmoidf_(float x) { return 1.0f / (1.0f + expf(-x)); }
DEVFN float gelu_tanh(float x) { return 0.5f * x * (1.0f + tanhf(0.7978845608028654f * (x + 0.044715f * x * x * x))); }
DEVFN int t5_bucket(int dist) {
    int n = dist > 0 ? dist : 0;
    if (n < 16) return n;
    float v = logf((float)n / 16.0f) / 4.1588830833596715f * 16.0f;
    int l = 16 + (int)v;
    return l < 31 ? l : 31;
}

DEVFN int vperm16(int s) { return (s & ~15) | (8 * ((s >> 2) & 1) + 4 * ((s >> 3) & 1) + (s & 3)); }
DEVFN int vperm32(int s) { return (s & ~31) | (8 * ((s >> 2) & 3) + 4 * ((s >> 4) & 1) + (s & 3)); }
constexpr float LOG2E_ = 1.4426950408889634f;

#ifdef CPU_EMU
struct dim3_ { int x; };
static thread_local dim3_ threadIdx, blockIdx;
static dim3_ blockDim, gridDim;
#endif
#ifdef CPU_EMU
#define TIDX ((int)threadIdx.x)
#else
extern __shared__ __attribute__((aligned(16))) unsigned char g_lds[];
constexpr int LDS_TOP = 148480;
constexpr int LDS_SLOT_OFF = LDS_TOP - 16 - 256;
__device__ __forceinline__ int my_tid() {
    const unsigned hw = (unsigned)__builtin_amdgcn_s_getreg((5 << 11) | 4) & 63u;
    const int slot = ((volatile __attribute__((address_space(3))) int*)((__attribute__((address_space(3))) unsigned char*)g_lds + LDS_SLOT_OFF))[hw];
    return (__builtin_amdgcn_readfirstlane(slot) << 6) | (int)__builtin_amdgcn_mbcnt_hi(~0u, __builtin_amdgcn_mbcnt_lo(~0u, 0u));
}
#define TIDX my_tid()
#endif
#define GTID ((int)(blockIdx.x * blockDim.x + TIDX))
#define GSZ ((int)(gridDim.x * blockDim.x))

template <int C>
DEVFN void norm_rows_bf16(const float* src, int lds_, const float* gain, bf16_t* dst, int ldd, int nrows) {
#ifdef CPU_EMU
    for (int r = GTID; r < nrows; r += GSZ) {
        float ss = 0.f; for (int i = 0; i < C; ++i) { float v = src[(size_t)r * lds_ + i]; ss += v * v; }
        const float rstd = 1.0f / sqrtf(ss / C + EPS_);
        for (int i = 0; i < C; ++i) dst[(size_t)r * ldd + i] = f2bf(src[(size_t)r * lds_ + i] * rstd * gain[i]);
    }
#else
    const int lane = TIDX & 63, gw = GTID >> 6, nw = GSZ >> 6;
    constexpr int PER = C / 64;
    for (int r0 = gw; r0 < nrows; r0 += 2 * nw) {
        const int r1 = r0 + nw; const bool has1 = r1 < nrows;
        float v0[PER], v1[PER]; float s0 = 0.f, s1 = 0.f;
#pragma unroll
        for (int j = 0; j < PER; ++j) { v0[j] = src[(size_t)r0 * lds_ + j * 64 + lane]; v1[j] = has1 ? src[(size_t)r1 * lds_ + j * 64 + lane] : 0.f; }
#pragma unroll
        for (int j = 0; j < PER; ++j) { s0 += v0[j] * v0[j]; s1 += v1[j] * v1[j]; }
#pragma unroll
        for (int o = 1; o < 64; o <<= 1) { s0 += __shfl_xor(s0, o); s1 += __shfl_xor(s1, o); }
        const float rs0 = 1.0f / sqrtf(s0 / C + EPS_), rs1 = 1.0f / sqrtf(s1 / C + EPS_);
#pragma unroll
        for (int j = 0; j < PER; ++j) { const float g = gain[j * 64 + lane]; dst[(size_t)r0 * ldd + j * 64 + lane] = f2bf(v0[j] * rs0 * g); if (has1) dst[(size_t)r1 * ldd + j * 64 + lane] = f2bf(v1[j] * rs1 * g); }
    }
#endif
}

typedef unsigned u32x4e __attribute__((ext_vector_type(4)));
DEVFN void transpose_cvt(const float* W, int K, int N, int Npad, bf16_t* WT, const float* gain = nullptr, int headperm = 0) {
    const int nitem = Npad * (K / 8); const int gs = GSZ;
    for (int it0 = GTID; it0 < nitem; it0 += 4 * gs) {
        float v[4][8]; int ndv[4], k8v[4];
#pragma unroll
        for (int u = 0; u < 4; ++u) { const int it = it0 + u * gs; const int nd = it % Npad, k8 = it / Npad; ndv[u] = nd; k8v[u] = k8;
            const int rho = nd & 255, r32 = nd & 31, n = headperm == 1 ? (nd & ~255) + 64 * ((rho >> 5) & 3) + 32 * (rho >> 7) + (rho & 31) : headperm == 2 ? (nd & ~31) + 8 * ((r32 & 15) >> 2) + 4 * (r32 >> 4) + (r32 & 3) : nd;
            const bool ok = it < nitem && n < N;
#pragma unroll
            for (int j = 0; j < 8; ++j) v[u][j] = ok ? W[(size_t)(k8 * 8 + j) * N + n] : 0.f; }
#pragma unroll
        for (int u = 0; u < 4; ++u) { if (it0 + u * gs >= nitem) break;
            unsigned o[4];
#pragma unroll
            for (int j = 0; j < 4; ++j) { float a = v[u][2 * j], b = v[u][2 * j + 1];
                if (gain) { a *= gain[k8v[u] * 8 + 2 * j]; b *= gain[k8v[u] * 8 + 2 * j + 1]; }
                o[j] = (unsigned)f2bf(a) | ((unsigned)f2bf(b) << 16); }
            *(u32x4e*)(WT + (size_t)ndv[u] * K + k8v[u] * 8) = (u32x4e){o[0], o[1], o[2], o[3]}; }
    }
}


#ifndef CPU_EMU
__device__ __forceinline__ void transpose_cvt_lds(const float* W, int K, int N, int Npad, bf16_t* WT, const float* gain = nullptr, bool headperm = false) {
    typedef __attribute__((address_space(3))) float lds_f;
    const int tid = TIDX, lane = tid & 63, wv = tid >> 6, gw = (int)(blockIdx.x * 8 + wv), nw = (int)gridDim.x * 8;
    lds_f* scr = (lds_f*)((__attribute__((address_space(3))) unsigned char*)g_lds) + wv * (64 * 33);
    const int nblk = Npad / 32, nitem = (K / 64) * nblk;
    for (int it = gw; it < nitem; it += nw) {
        const int kb = it / nblk, nb = it - kb * nblk, k0 = kb * 64, nd0 = nb * 32;
        const int rho = nd0 & 255, ns0 = headperm ? (nd0 & ~255) + 64 * ((rho >> 5) & 3) + 32 * (rho >> 7) : nd0;
        const int n = lane & 31; const bool inb = ns0 + n < N;
#pragma unroll 8
        for (int i = 0; i < 32; ++i) { const int kk = 2 * i + (lane >> 5); float v = inb ? W[(size_t)(k0 + kk) * N + ns0 + n] : 0.f; if (gain) v *= gain[k0 + kk]; scr[kk * 33 + n] = v; }
        asm volatile("s_waitcnt lgkmcnt(0)" ::: "memory");
        const int c = lane & 7;
#pragma unroll
        for (int j = 0; j < 4; ++j) { const int nn = (lane >> 3) + 8 * j; const lds_f* sp = scr + (8 * c) * 33 + nn;
            u32x4e o; o.x = (unsigned)f2bf(sp[0]) | ((unsigned)f2bf(sp[33]) << 16); o.y = (unsigned)f2bf(sp[66]) | ((unsigned)f2bf(sp[99]) << 16);
            o.z = (unsigned)f2bf(sp[132]) | ((unsigned)f2bf(sp[165]) << 16); o.w = (unsigned)f2bf(sp[198]) | ((unsigned)f2bf(sp[231]) << 16);
            *(u32x4e*)(WT + (size_t)(nd0 + nn) * K + k0 + 8 * c) = o; }
        asm volatile("s_waitcnt lgkmcnt(0)" ::: "memory");
    }
}
__device__ __forceinline__ void transpose_cvt_w(const float* W, int K, int N, int Npad, bf16_t* WT, const float* gain = nullptr, int headperm = 0) {
    const int lane = TIDX & 63, gw = __builtin_amdgcn_readfirstlane((int)(GTID >> 6)), nw = GSZ >> 6, l4 = lane >> 2, kq = lane & 3;
    const int nb16 = Npad / 16, nitem = nb16 * (K / 32);
    for (int it0 = gw; it0 < nitem; it0 += 4 * nw) {
        float v[4][8];
#pragma unroll
        for (int u = 0; u < 4; ++u) { const int it = it0 + u * nw; const int nd = (it % nb16) * 16 + l4, k8 = (it / nb16) * 4 + kq;
            const int rho = nd & 255, r32 = nd & 31, n = headperm == 1 ? (nd & ~255) + 64 * ((rho >> 5) & 3) + 32 * (rho >> 7) + (rho & 31) : headperm == 2 ? (nd & ~31) + 8 * ((r32 & 15) >> 2) + 4 * (r32 >> 4) + (r32 & 3) : nd;
            const bool ok = it < nitem && n < N;
#pragma unroll
            for (int j = 0; j < 8; ++j) v[u][j] = ok ? W[(size_t)(k8 * 8 + j) * N + n] : 0.f; }
#pragma unroll
        for (int u = 0; u < 4; ++u) { const int it = it0 + u * nw; if (it >= nitem) break;
            const int nd = (it % nb16) * 16 + l4, k8 = (it / nb16) * 4 + kq;
            unsigned o[4];
#pragma unroll
            for (int j = 0; j < 4; ++j) { float a = v[u][2 * j], b = v[u][2 * j + 1];
                if (gain) { a *= gain[k8 * 8 + 2 * j]; b *= gain[k8 * 8 + 2 * j + 1]; }
                o[j] = (unsigned)f2bf(a) | ((unsigned)f2bf(b) << 16); }
            *(u32x4e*)(WT + (size_t)nd * K + k8 * 8) = (u32x4e){o[0], o[1], o[2], o[3]}; }
    }
}
#define TRANSPOSE_CVT transpose_cvt_w
#else
#define TRANSPOSE_CVT transpose_cvt
#endif

DEVFN void ph_prologue(const Params& p) {
    unsigned char* ws = p.ws;
#ifdef CPU_EMU
    TRANSPOSE_CVT(p.in[I_HYIN], 1024, HYIN, HYIN_P, (bf16_t*)(ws + W_HYIN));
#else
    TRANSPOSE_CVT(p.in[I_HYIN], 1024, HYIN, HYIN_P, (bf16_t*)(ws + W_HYIN), nullptr, 2);
#endif
#ifdef CPU_EMU
    TRANSPOSE_CVT(p.in[I_WUQ], 384, 768, 768, (bf16_t*)(ws + W_UQ));
#else
    TRANSPOSE_CVT(p.in[I_WUQ], 384, 768, 768, (bf16_t*)(ws + W_UQ), nullptr, 2);
#endif
#ifdef CPU_EMU
    TRANSPOSE_CVT(p.in[I_WUKV], 256, 1024, 1024, (bf16_t*)(ws + W_UKV));
#else
    TRANSPOSE_CVT(p.in[I_WUKV], 256, 1024, 1024, (bf16_t*)(ws + W_UKV), nullptr, 1);
#endif
#ifdef CPU_EMU
    TRANSPOSE_CVT(p.in[I_HYOUT], 1024, 1024, 1024, (bf16_t*)(ws + W_HYOUT));
#else
    TRANSPOSE_CVT(p.in[I_HYOUT], 1024, 1024, 1024, (bf16_t*)(ws + W_HYOUT), nullptr, 2);
#endif
    for (int l = 0; l < 2; ++l) {
#ifdef CPU_EMU
        TRANSPOSE_CVT(p.in[I_W1] + (size_t)l * 1024 * 4096, 1024, 4096, 4096, (bf16_t*)(ws + W_MLP1) + (size_t)l * 4096 * 1024);
#else
        TRANSPOSE_CVT(p.in[I_W1] + (size_t)l * 1024 * 4096, 1024, 4096, 4096, (bf16_t*)(ws + W_MLP1) + (size_t)l * 4096 * 1024, p.in[I_NMLP] + l * 1024, 2);
#endif
#ifdef CPU_EMU
        TRANSPOSE_CVT(p.in[I_W2] + (size_t)l * 4096 * 1024, 4096, 1024, 1024, (bf16_t*)(ws + W_MLP2) + (size_t)l * 4096 * 1024);
#else
        TRANSPOSE_CVT(p.in[I_W2] + (size_t)l * 4096 * 1024, 4096, 1024, 1024, (bf16_t*)(ws + W_MLP2) + (size_t)l * 4096 * 1024, nullptr, 2);
#endif
    }
#ifdef CPU_EMU
    TRANSPOSE_CVT(p.in[I_NSAIN], 1024, NSAIN, NSAIN_P, (bf16_t*)(ws + W_NSAIN));
#else
    TRANSPOSE_CVT(p.in[I_NSAIN], 1024, NSAIN, NSAIN_P, (bf16_t*)(ws + W_NSAIN), p.in[I_NMIX] + 1024, 1);
#endif
    TRANSPOSE_CVT(p.in[I_C1K], 2048, 256, 256, (bf16_t*)(ws + W_C1K));
    TRANSPOSE_CVT(p.in[I_C1V], 2048, 256, 256, (bf16_t*)(ws + W_C1V));
#ifdef CPU_EMU
    TRANSPOSE_CVT(p.in[I_NSAOUT], 1024, 1024, 1024, (bf16_t*)(ws + W_NSAOUT));
#else
    TRANSPOSE_CVT(p.in[I_NSAOUT], 1024, 1024, 1024, (bf16_t*)(ws + W_NSAOUT), nullptr, 2);
#endif
#ifndef CPU_EMU
    {
        bf16_t* WG = (bf16_t*)(ws + W_GATE); const float *wa = p.in[I_WA], *wx = p.in[I_WX];
        for (int it = GTID; it < 1024 * 64; it += GSZ) {
            const int nd = it & 1023, k8 = it >> 10, c = nd >> 1, gsel = nd & 1, bn = c >> 6, e = c & 63;
            unsigned o[4] = {0u, 0u, 0u, 0u};
            if ((k8 >> 3) == bn) { const float* w = gsel ? wx : wa;
#pragma unroll
                for (int j = 0; j < 4; ++j) { const int d0 = (k8 & 7) * 8 + 2 * j; o[j] = (unsigned)f2bf(w[(bn * 64 + d0) * 64 + e]) | ((unsigned)f2bf(w[(bn * 64 + d0 + 1) * 64 + e]) << 16); } }
            *(u32x4e*)(WG + (size_t)nd * 512 + k8 * 8) = (u32x4e){o[0], o[1], o[2], o[3]};
        }
    }
#endif
#ifndef CPU_EMU
    if (blockIdx.x == 0 && TIDX < 64) {
        const int lane = TIDX;
        float mq0 = 0.f, mk0 = 0.f, mq1 = 0.f, mkc = 0.f, mks = 0.f, mkw = 0.f, mb = 0.f;
        for (int i = lane; i < 96; i += 64) { mq0 = fmaxf(mq0, fabsf(p.in[I_QNQ][i])); mk0 = fmaxf(mk0, fabsf(p.in[I_QNK][i])); }
        mq1 = fabsf(p.in[I_NQN][lane]); mkc = fabsf(p.in[I_NKN][lane]); mks = fabsf(p.in[I_NKN][64 + lane]); mkw = fabsf(p.in[I_NKN][128 + lane]);
        for (int i = lane; i < 512; i += 64) mb = fmaxf(mb, fabsf(p.in[I_RELB][i]));
#pragma unroll
        for (int o = 1; o < 64; o <<= 1) { mq0 = fmaxf(mq0, __shfl_xor(mq0, o)); mk0 = fmaxf(mk0, __shfl_xor(mk0, o)); mq1 = fmaxf(mq1, __shfl_xor(mq1, o)); mkc = fmaxf(mkc, __shfl_xor(mkc, o));
            mks = fmaxf(mks, __shfl_xor(mks, o)); mkw = fmaxf(mkw, __shfl_xor(mkw, o)); mb = fmaxf(mb, __shfl_xor(mb, o)); }
        if (lane == 0) { float* bd = (float*)(ws + OFF_BOUND);
            bd[0] = -(9.797958971f * mq0 * mk0 * LOG2E_ * 1.02f + 0.05f);
            bd[1] = -((8.0f * mq1 * mkc + mb) * LOG2E_ * 1.02f + 0.05f);
            bd[2] = -((8.0f * mq1 * mks + mb) * LOG2E_ * 1.02f + 0.05f);
            bd[3] = -((8.0f * mq1 * mkw + mb) * LOG2E_ * 1.02f + 0.05f); }
    }
#endif
#ifndef CPU_EMU
    for (int i = GTID; i < 4096; i += GSZ) ((unsigned char*)(ws + OFF_BKT))[i] = (unsigned char)t5_bucket(i);
    { float* rc = (float*)(ws + OFF_ROPE); float* rs = rc + (size_t)S_ * 16;
      for (int i = GTID; i < S_ * 16; i += GSZ) { const float ang = (float)(i >> 4) * powf(10000.0f, -(float)(i & 15) / 16.0f); rc[i] = cosf(ang); rs[i] = sinf(ang); } }
#endif
    float* cb = (float*)(ws + OFF_CBIAS);
#ifdef CPU_EMU
    for (int it = GTID; it < 512; it += GSZ) {
        const int kv = it >> 8, e = it & 255;
        const float* pos = p.in[kv ? I_POSV : I_POSK]; const float* w1 = p.in[kv ? I_C1V : I_C1K];
        float acc = 0.f;
        for (int k = 0; k < 2048; ++k) acc += pos[k] * w1[(size_t)k * 256 + e];
        cb[it] = acc;
    }
#else
    {
        float* part = cb + 512;
        const int lane = TIDX & 63, gw = GTID >> 6, nw = GSZ >> 6;
        for (int it = gw; it < 2 * 4 * 16; it += nw) {
            const int kv = it >> 6, cg4 = (it >> 4) & 3, ksl = it & 15, e = cg4 * 64 + lane;
            const float* pos = p.in[kv ? I_POSV : I_POSK]; const float* w1 = p.in[kv ? I_C1V : I_C1K];
            float acc = 0.f;
#pragma unroll 8
            for (int k = ksl * 128; k < ksl * 128 + 128; ++k) acc += pos[k] * w1[(size_t)k * 256 + e];
            part[ksl * 512 + kv * 256 + e] = acc;
        }
    }
#endif
    norm_rows_bf16<1024>(p.in[I_X], 1024, p.in[I_NMIX], (bf16_t*)(ws + OFF_XN), 1024, T_);
}

DEVFN void ph_l0_a(const Params& p) {
    const float* z0 = (const float*)(p.ws + OFF_BIG);
    float* xc = (float*)(p.ws + OFF_XN);
    const float* cw = p.in[I_CONVW]; const float* cbias = p.in[I_CONVB];
    for (int it = GTID; it < T_ * 512; it += GSZ) {
        const int c = it & 511, t = it >> 9, s = t % S_;
        float acc = cbias[c];
#pragma unroll
        for (int k = 0; k < 4; ++k) { const int ss = s - 3 + k; if (ss >= 0) acc += cw[k * 512 + c] * z0[(size_t)(t - 3 + k) * HYIN_P + c]; }
        xc[it] = acc;
    }
    norm_rows_bf16<384>(z0 + 1024, HYIN_P, p.in[I_QNORM], (bf16_t*)((unsigned char*)p.out + DO_QLAT), 384, T_);
    norm_rows_bf16<256>(z0 + 1408, HYIN_P, p.in[I_KVNORM], (bf16_t*)((unsigned char*)p.out + DO_KVLAT), 256, T_);
    float* kr = (float*)(p.ws + SM_KROPE);
    for (int it = GTID; it < T_ * 32; it += GSZ) kr[it] = z0[(size_t)(it >> 5) * HYIN_P + 1664 + (it & 31)];
#ifndef CPU_EMU
    { float* cb = (float*)(p.ws + OFF_CBIAS); const float* part = cb + 512;
      for (int it = GTID; it < 512; it += GSZ) { float a = 0.f; for (int k = 0; k < 16; ++k) a += part[k * 512 + it]; cb[it] = a; } }
#endif
}

DEVFN void ph_l0_b(const Params& p) {
    float* z0 = (float*)(p.ws + OFF_BIG);
    const float* xc = (const float*)(p.ws + OFF_XN);
    const float *wa = p.in[I_WA], *ba = p.in[I_BA], *wx = p.in[I_WX], *bx = p.in[I_BX], *lam = p.in[I_LAM];
    for (int it = GTID; it < T_ * 512; it += GSZ) {
        const int c = it & 511, t = it >> 9, s = t % S_, n = c >> 6, e = c & 63;
        float accA = ba[c], accX = bx[c];
        const float* xrow = xc + (size_t)t * 512 + n * 64;
        for (int d = 0; d < 64; ++d) { const float xv = xrow[d]; accA += xv * wa[(n * 64 + d) * 64 + e]; accX += xv * wx[(n * 64 + d) * 64 + e]; }
        const float r = sigmoidf_(accA), ig = sigmoidf_(accX);
        const float sp = log1pf(expf(-lam[c]));
        const float log_a = -8.0f * r * sp;
        const float a = expf(log_a);
        const float mult = (s == 0) ? 1.0f : sqrtf(-expm1f(2.0f * log_a));
        z0[(size_t)t * HYIN_P + c] = a;
        z0[(size_t)t * HYIN_P + 1024 + c] = mult * (ig * xc[it]);
    }
}

DEVFN void ph_l0_scan(const Params& p) {
    float* z0 = (float*)(p.ws + OFF_BIG);
    for (int it = GTID; it < B_ * NCH_ * 512; it += GSZ) {
        const int c = it & 511, ch = (it >> 9) % NCH_, b = it / (512 * NCH_);
        float h = 0.f, P = 1.f;
        size_t base = ((size_t)b * S_ + ch * 64) * HYIN_P + c;
        for (int j = 0; j < 64; ++j) {
            const float a = z0[base + (size_t)j * HYIN_P], bb = z0[base + (size_t)j * HYIN_P + 1024];
            h = a * h + bb; P *= a;
            z0[base + (size_t)j * HYIN_P] = P; z0[base + (size_t)j * HYIN_P + 1024] = h;
        }
    }
}

DEVFN void ph_l0_fix(const Params& p) {
    const float* z0 = (const float*)(p.ws + OFF_BIG);
    bf16_t* cat = (bf16_t*)(p.ws + SM_CAT);
    for (int it = GTID; it < B_ * NCH_ * 512; it += GSZ) {
        const int c = it & 511, ch = (it >> 9) % NCH_, b = it / (512 * NCH_);
        float carry = 0.f;
        for (int k = 0; k < ch; ++k) { const size_t tl = ((size_t)b * S_ + k * 64 + 63) * HYIN_P + c; carry = z0[tl] * carry + z0[tl + 1024]; }
        for (int j = 0; j < 64; ++j) {
            const size_t t = (size_t)b * S_ + ch * 64 + j;
            const float h = z0[t * HYIN_P + 1024 + c] + z0[t * HYIN_P + c] * carry;
            cat[t * 1024 + c] = f2bf(h * gelu_tanh(z0[t * HYIN_P + 512 + c]));
        }
    }
}


#ifndef CPU_EMU
template <int C>
__device__ __forceinline__ void norm_rows_bf16_b(const bf16_t* src, int lds_, const float* gain, bf16_t* dst, int ldd, int nrows) {
    const int lane = TIDX & 63, gw = GTID >> 6, nw = GSZ >> 6;
    constexpr int PER = C / 128;
    for (int r0 = gw; r0 < nrows; r0 += 4 * nw) {
        unsigned v[4][PER]; float ss[4];
#pragma unroll
        for (int q = 0; q < 4; ++q) { const int r = r0 + q * nw;
#pragma unroll
            for (int j = 0; j < PER; ++j) v[q][j] = r < nrows ? *(const unsigned*)(src + (size_t)r * lds_ + (j * 64 + lane) * 2) : 0u; }
#pragma unroll
        for (int q = 0; q < 4; ++q) { float a = 0.f;
#pragma unroll
            for (int j = 0; j < PER; ++j) { const float x0 = u2f(v[q][j] << 16), x1 = u2f(v[q][j] & 0xffff0000u); a += x0 * x0 + x1 * x1; }
            ss[q] = a; }
#pragma unroll
        for (int o = 1; o < 64; o <<= 1)
#pragma unroll
            for (int q = 0; q < 4; ++q) ss[q] += __shfl_xor(ss[q], o);
#pragma unroll
        for (int q = 0; q < 4; ++q) { const int r = r0 + q * nw; if (r >= nrows) break; const float rs = 1.0f / sqrtf(ss[q] / C + EPS_);
#pragma unroll
            for (int j = 0; j < PER; ++j) { const float g0 = gain[(j * 64 + lane) * 2], g1 = gain[(j * 64 + lane) * 2 + 1];
                *(unsigned*)(dst + (size_t)r * ldd + (j * 64 + lane) * 2) = (unsigned)f2bf(u2f(v[q][j] << 16) * rs * g0) | ((unsigned)f2bf(u2f(v[q][j] & 0xffff0000u) * rs * g1) << 16); } }
    }
}
__device__ __forceinline__ void ph_l0_a_gpu(const Params& p) {
    const bf16_t* z0 = (const bf16_t*)(p.ws + OFF_BIG);
    bf16_t* xc = (bf16_t*)(p.ws + OFF_XN);
    const float* cw = p.in[I_CONVW]; const float* cbias = p.in[I_CONVB];
    {
        const int gt = GTID, gs = GSZ;
        for (int it0 = gt; it0 < T_ * 64; it0 += 2 * gs) {
            u32x4e zr[2][4];
#pragma unroll
            for (int u = 0; u < 2; ++u) { const int it = it0 + u * gs; const int c = (it & 63) * 8, t = it >> 6, s = t % S_;
#pragma unroll
                for (int k = 0; k < 4; ++k) { const int ss = s - 3 + k; zr[u][k] = (it < T_ * 64 && ss >= 0) ? *(const u32x4e*)(z0 + (size_t)(t - 3 + k) * HYIN_P + c) : (u32x4e){0u, 0u, 0u, 0u}; } }
#pragma unroll
            for (int u = 0; u < 2; ++u) { const int it = it0 + u * gs; if (it >= T_ * 64) break; const int c = (it & 63) * 8, t = it >> 6;
                float a[8];
                { const f32x4 b0 = *(const f32x4*)(cbias + c), b1 = *(const f32x4*)(cbias + c + 4);
#pragma unroll
                  for (int j = 0; j < 4; ++j) { a[j] = b0[j]; a[4 + j] = b1[j]; } }
#pragma unroll
                for (int k = 0; k < 4; ++k) { const f32x4 w0 = *(const f32x4*)(cw + k * 512 + c), w1 = *(const f32x4*)(cw + k * 512 + c + 4); const u32x4e z = zr[u][k];
                    a[0] += w0[0] * u2f(z.x << 16); a[1] += w0[1] * u2f(z.x & 0xffff0000u); a[2] += w0[2] * u2f(z.y << 16); a[3] += w0[3] * u2f(z.y & 0xffff0000u);
                    a[4] += w1[0] * u2f(z.z << 16); a[5] += w1[1] * u2f(z.z & 0xffff0000u); a[6] += w1[2] * u2f(z.w << 16); a[7] += w1[3] * u2f(z.w & 0xffff0000u); }
                *(u32x4e*)(xc + (size_t)t * 512 + c) = (u32x4e){(unsigned)f2bf(a[0]) | ((unsigned)f2bf(a[1]) << 16), (unsigned)f2bf(a[2]) | ((unsigned)f2bf(a[3]) << 16),
                                                                 (unsigned)f2bf(a[4]) | ((unsigned)f2bf(a[5]) << 16), (unsigned)f2bf(a[6]) | ((unsigned)f2bf(a[7]) << 16)}; }
        }
    }
    norm_rows_bf16_b<384>(z0 + 1024, HYIN_P, p.in[I_QNORM], (bf16_t*)((unsigned char*)p.out + DO_QLAT), 384, T_);
    norm_rows_bf16_b<256>(z0 + 1408, HYIN_P, p.in[I_KVNORM], (bf16_t*)((unsigned char*)p.out + DO_KVLAT), 256, T_);
    float* kr = (float*)(p.ws + SM_KROPE);
    for (int it = GTID; it < T_ * 32; it += GSZ) kr[it] = bf2f(z0[(size_t)(it >> 5) * HYIN_P + 1664 + (it & 31)]);
    { float* cb = (float*)(p.ws + OFF_CBIAS); const float* part = cb + 512;
      for (int it = GTID; it < 512; it += GSZ) { float a = 0.f; for (int k = 0; k < 16; ++k) a += part[k * 512 + it]; cb[it] = a; } }
}
__device__ __forceinline__ void ph_l0_scan1_gpu(const Params& p) {
    const float* ab = (const float*)(p.ws + OFF_BIG + (size_t)T_ * 4096);
    float* AE = (float*)(p.ws + SM_SCAN); float* BE = AE + (size_t)B_ * NCH_ * 512;
    for (int it = GTID; it < B_ * NCH_ * 512; it += GSZ) {
        const int c = it & 511, ch = (it >> 9) % NCH_, b = it / (512 * NCH_);
        const float* base = ab + ((size_t)b * S_ + ch * 64) * 1024 + c;
        float h = 0.f, P = 1.f;
        {
            float av[64], bv[64];
#pragma unroll
            for (int k = 0; k < 64; ++k) { av[k] = base[(size_t)k * 1024]; bv[k] = base[(size_t)k * 1024 + 512]; }
#pragma unroll
            for (int k = 0; k < 64; ++k) { h = av[k] * h + bv[k]; P *= av[k]; }
        }
        AE[it] = P; BE[it] = h;
    }
}
__device__ __forceinline__ void ph_l0_scan2_gpu(const Params& p) {
    const bf16_t* z0 = (const bf16_t*)(p.ws + OFF_BIG); const float* ab = (const float*)(p.ws + OFF_BIG + (size_t)T_ * 4096);
    const float* AE = (const float*)(p.ws + SM_SCAN); const float* BE = AE + (size_t)B_ * NCH_ * 512;
    bf16_t* cat = (bf16_t*)(p.ws + SM_CAT);
    for (int it = GTID; it < B_ * NCH_ * 512; it += GSZ) {
        const int c = it & 511, ch = (it >> 9) % NCH_, b = it / (512 * NCH_);
        float h = 0.f;
        for (int k0 = 0; k0 < ch; k0 += 64) {
            float ae[64], be[64];
#pragma unroll
            for (int k = 0; k < 64; ++k) { const bool ok = k0 + k < ch; const size_t si = ((size_t)b * NCH_ + (ok ? k0 + k : 0)) * 512 + c; ae[k] = ok ? AE[si] : 1.f; be[k] = ok ? BE[si] : 0.f; }
#pragma unroll
            for (int k = 0; k < 64; ++k) h = ae[k] * h + be[k];
        }
        const size_t t0 = (size_t)b * S_ + ch * 64;
        const float* base = ab + t0 * 1024 + c; const bf16_t* gbase = z0 + t0 * HYIN_P + 512 + c;
        for (int j0 = 0; j0 < 64; j0 += 64) {
            float av[64], bv[64], gv[64];
#pragma unroll
            for (int k = 0; k < 64; ++k) { av[k] = base[(size_t)(j0 + k) * 1024]; bv[k] = base[(size_t)(j0 + k) * 1024 + 512]; gv[k] = bf2f(gbase[(size_t)(j0 + k) * HYIN_P]); }
#pragma unroll
            for (int k = 0; k < 64; ++k) { h = av[k] * h + bv[k]; cat[(t0 + j0 + k) * 1024 + c] = f2bf(h * gelu_tanh(gv[k])); }
        }
    }
}
#endif

DEVFN void ph_l0_hn(const Params& p) {
    const float* qraw = (const float*)(p.ws + OFF_BIG);
    const float* kvraw = qraw + (size_t)T_ * 768;
    const float* kr = (const float*)(p.ws + SM_KROPE);
    bf16_t* Q0 = (bf16_t*)(p.ws + OFF_XN);
    bf16_t* K0 = (bf16_t*)((unsigned char*)p.out + DO_K0);
    bf16_t* V0 = (bf16_t*)((unsigned char*)p.out + DO_V0);
    const float *gq = p.in[I_QNQ], *gk = p.in[I_QNK];
    const float scale = 0.10206207261596577f * LOG2E_;
    for (int it = GTID; it < T_ * 8 * 2; it += GSZ) {
        const int t = it % T_, h = (it / T_) & 7, isk = it / (T_ * 8);
        const int b = t / S_, s = t % S_;
        const float* src0 = isk ? kvraw + (size_t)t * 1024 + h * 128 : qraw + (size_t)t * 768 + h * 96;
        const float* src1 = isk ? kr + (size_t)t * 32 : qraw + (size_t)t * 768 + h * 96 + 64;
        float ss = 0.f;
        for (int i = 0; i < 64; ++i) { const float x = src0[i]; ss += x * x; }
        for (int i = 0; i < 32; ++i) { const float x = src1[i]; ss += x * x; }
        const float rstd = 1.0f / sqrtf(ss / 96.0f + EPS_);
        const float* g = isk ? gk : gq;
        const float sc = isk ? 1.0f : scale;
        bf16_t* dst = (isk ? K0 : Q0) + ((size_t)(b * 8 + h) * S_ + s) * 96;
        for (int i = 0; i < 64; ++i) dst[i] = f2bf(src0[i] * rstd * g[i] * sc);
        for (int i = 0; i < 16; ++i) {
            const float freq = powf(10000.0f, -(float)i / 16.0f);
            const float ang = (float)s * freq; const float cs = cosf(ang), sn = sinf(ang);
            const float x1 = src1[i] * rstd * g[64 + i], x2 = src1[16 + i] * rstd * g[80 + i];
            dst[64 + i] = f2bf((x1 * cs - x2 * sn) * sc); dst[80 + i] = f2bf((x2 * cs + x1 * sn) * sc);
        }
        if (isk) {
            bf16_t* dv = V0 + (size_t)(b * 8 + h) * 64 * S_ + vperm16(s);
            for (int i = 0; i < 64; ++i) dv[(size_t)i * S_] = f2bf(kvraw[(size_t)t * 1024 + h * 128 + 64 + i]);
        }
    }
}


#ifndef CPU_EMU
__device__ __forceinline__ void ph_l0_hn_gpu(const Params& p) {
    const float* qraw = (const float*)(p.ws + OFF_BIG);
    const float* kvraw = qraw + (size_t)T_ * 768;
    const float* kr = (const float*)(p.ws + SM_KROPE);
    bf16_t* Q0 = (bf16_t*)(p.ws + OFF_XN);
    bf16_t* K0 = (bf16_t*)((unsigned char*)p.out + DO_K0);
    bf16_t* V0 = (bf16_t*)((unsigned char*)p.out + DO_V0);
    const int tid = TIDX, lane = tid & 63, gw = (int)(blockIdx.x * 8 + (tid >> 6)), nw = (int)gridDim.x * 8;
    const float gq0 = p.in[I_QNQ][lane], gk0 = p.in[I_QNK][lane];
    const float gq1 = lane < 32 ? p.in[I_QNQ][64 + lane] : 0.f, gk1 = lane < 32 ? p.in[I_QNK][64 + lane] : 0.f;
    const float freq = powf(10000.0f, -(float)(lane & 15) / 16.0f);
    const float qscale = 0.10206207261596577f * LOG2E_;
    for (int t = gw; t < T_; t += nw) {
        const int b = t / S_, s = t - b * S_;
        float xq0[8], xq1[8], xk0[8], vv[8];
#pragma unroll
        for (int h = 0; h < 8; ++h) { xq0[h] = qraw[(size_t)t * 768 + h * 96 + lane]; xq1[h] = lane < 32 ? qraw[(size_t)t * 768 + h * 96 + 64 + lane] : 0.f;
            xk0[h] = kvraw[(size_t)t * 1024 + h * 128 + lane]; vv[h] = kvraw[(size_t)t * 1024 + h * 128 + 64 + lane]; }
        const float krv = lane < 32 ? kr[(size_t)t * 32 + lane] : 0.f;
        const float ang = (float)s * freq; const float cs = cosf(ang), sn = sinf(ang);
#pragma unroll
        for (int it = 0; it < 16; ++it) {
            const int h = it & 7, isk = it >> 3;
            const float x0 = isk ? xk0[h] : xq0[h], x1 = isk ? krv : xq1[h];
            float ss = x0 * x0 + x1 * x1;
#pragma unroll
            for (int o = 1; o < 64; o <<= 1) ss += __shfl_xor(ss, o);
            const float rstd = 1.0f / sqrtf(ss / 96.0f + EPS_);
            const float sc = isk ? 1.0f : qscale;
            const float y0 = x0 * rstd * (isk ? gk0 : gq0) * sc, y1 = x1 * rstd * (isk ? gk1 : gq1) * sc;
            const float pr = __shfl_xor(y1, 16);
            const float ro = (lane & 16) ? y1 * cs + pr * sn : y1 * cs - pr * sn;
            bf16_t* dst = (isk ? K0 : Q0) + ((size_t)(b * 8 + h) * S_ + s) * 96;
            dst[lane] = f2bf(y0);
            if (lane < 32) dst[64 + lane] = f2bf(ro);
            if (isk) V0[((size_t)(b * 8 + h) * 64 + lane) * S_ + vperm16(s)] = f2bf(vv[h]);
        }
    }
}
#endif

DEVFN void ph_l0_attn(const Params& p) {
    const bf16_t* Q0 = (const bf16_t*)(p.ws + OFF_XN);
    const bf16_t* K0 = (const bf16_t*)((const unsigned char*)p.out + DO_K0);
    const bf16_t* V0 = (const bf16_t*)((const unsigned char*)p.out + DO_V0);
    bf16_t* cat = (bf16_t*)(p.ws + SM_CAT);
    for (int it = GTID; it < T_ * 8; it += GSZ) {
        const int q = it % S_, bh = it / S_;
        float qv[96], o[64];
        const bf16_t* qp = Q0 + ((size_t)bh * S_ + q) * 96;
#pragma unroll
        for (int i = 0; i < 96; ++i) qv[i] = bf2f(qp[i]);
#pragma unroll
        for (int i = 0; i < 64; ++i) o[i] = 0.f;
        float m = -1e30f, l = 0.f;
        for (int j = 0; j <= q; ++j) {
            const bf16_t* kp = K0 + ((size_t)bh * S_ + j) * 96; const bf16_t* vp = V0 + (size_t)bh * 64 * S_ + vperm16(j);
            float s = 0.f;
#pragma unroll
            for (int i = 0; i < 96; ++i) s += qv[i] * bf2f(kp[i]);
            if (s > m) { const float cr = exp2f(m - s); l *= cr;
#pragma unroll
                for (int i = 0; i < 64; ++i) o[i] *= cr;
                m = s; }
            const float pe = exp2f(s - m); l += pe;
#pragma unroll
            for (int i = 0; i < 64; ++i) o[i] += pe * bf2f(vp[(size_t)i * S_]);
        }
        const float inv = 1.0f / l; const int b = bh >> 3, h = bh & 7;
        bf16_t* dst = cat + ((size_t)b * S_ + q) * 1024 + 512 + h * 64;
#pragma unroll
        for (int i = 0; i < 64; ++i) dst[i] = f2bf(o[i] * inv);
    }
}


#ifndef CPU_EMU
#define LAS __attribute__((address_space(3)))
typedef short bf16x8_t __attribute__((ext_vector_type(8)));
typedef float f32x16 __attribute__((ext_vector_type(16)));
typedef float f32x2_t __attribute__((ext_vector_type(2)));
typedef __bf16 bf16x2_t __attribute__((ext_vector_type(2)));
typedef unsigned u32x4_t __attribute__((ext_vector_type(4)));
__device__ __forceinline__ unsigned cvtpk(float lo, float hi) { f32x2_t v = {lo, hi}; bf16x2_t b = __builtin_convertvector(v, bf16x2_t); return __builtin_bit_cast(unsigned, b); }
#define GLD16(DST, PTR) asm volatile("global_load_dwordx4 %0, %1, off" : "=v"(DST) : "v"(PTR) : "memory")
__device__ __forceinline__ int crow(int r, int hi) { return (r & 3) + 8 * (r >> 2) + 4 * hi; }
__device__ __forceinline__ bf16x8_t pack8(const f32x16& p, int base) {
    u32x4_t w; w.x = cvtpk(p[base], p[base + 1]); w.y = cvtpk(p[base + 2], p[base + 3]); w.z = cvtpk(p[base + 4], p[base + 5]); w.w = cvtpk(p[base + 6], p[base + 7]);
    return __builtin_bit_cast(bf16x8_t, w);
}

__device__ __forceinline__ void mla_tile(LAS unsigned char* lds, int cur, int kt, const bf16x8_t (&qf)[6], f32x16& o0, f32x16& o1, float& l, float negB2, int qw0, int qg, int r, int hh) {
    constexpr int KROW = 208, VROW = 144, KT_B = 64 * KROW;
    f32x16 s0, s1;
#pragma unroll
    for (int i = 0; i < 16; ++i) { s0[i] = negB2; s1[i] = negB2; }
#pragma unroll
    for (int ks = 0; ks < 6; ++ks) {
        const bf16x8_t k0 = *(const LAS bf16x8_t*)(lds + cur + r * KROW + (16 * ks + 8 * hh) * 2);
        const bf16x8_t k1 = *(const LAS bf16x8_t*)(lds + cur + (32 + r) * KROW + (16 * ks + 8 * hh) * 2);
        s0 = __builtin_amdgcn_mfma_f32_32x32x16_bf16(k0, qf[ks], s0, 0, 0, 0);
        s1 = __builtin_amdgcn_mfma_f32_32x32x16_bf16(k1, qf[ks], s1, 0, 0, 0);
    }
    const bool need_mask = 64 * kt + 63 > qw0;
    float ls = 0.f;
    int hq = hh, qq = qg; asm volatile("" : "+v"(hq), "+v"(qq));
#pragma unroll
    for (int i = 0; i < 16; ++i) {
        float p0 = __builtin_amdgcn_exp2f(s0[i]), p1 = __builtin_amdgcn_exp2f(s1[i]);
        if (need_mask) { const int key = 64 * kt + crow(i, hq); if (key > qq) p0 = 0.f; if (key + 32 > qq) p1 = 0.f; }
        s0[i] = p0; s1[i] = p1; ls += p0 + p1;
    }
    l += ls;
    const bf16x8_t pa = pack8(s0, 0), pb = pack8(s0, 8), pc = pack8(s1, 0), pd = pack8(s1, 8);
    const LAS unsigned char* vb = lds + cur + KT_B + r * VROW + 8 * hh * 2;
#define PV_STEP(PF, SP) do { const bf16x8_t v0 = *(const LAS bf16x8_t*)(vb + (SP) * 32); const bf16x8_t v1 = *(const LAS bf16x8_t*)(vb + 32 * VROW + (SP) * 32); \
        o0 = __builtin_amdgcn_mfma_f32_32x32x16_bf16(PF, v0, o0, 0, 0, 0); o1 = __builtin_amdgcn_mfma_f32_32x32x16_bf16(PF, v1, o1, 0, 0, 0); } while (0)
    PV_STEP(pa, 0); PV_STEP(pb, 1); PV_STEP(pc, 2); PV_STEP(pd, 3);
#undef PV_STEP
}

__device__ __forceinline__ void ph_l0_attn_mfma(const Params& p) {
    constexpr int KROW = 208, VROW = 144, KT_B = 64 * KROW, VT_B = 64 * VROW, BUF_B = KT_B + VT_B;
    LAS unsigned char* lds = (LAS unsigned char*)g_lds;
    const bf16_t* Q0 = (const bf16_t*)(p.ws + OFF_XN);
    const bf16_t* K0 = (const bf16_t*)((const unsigned char*)p.out + DO_K0);
    const bf16_t* V0 = (const bf16_t*)((const unsigned char*)p.out + DO_V0);
    bf16_t* cat = (bf16_t*)(p.ws + SM_CAT);
    const int tid = TIDX, lane = tid & 63, w = __builtin_amdgcn_readfirstlane(tid >> 6), r = lane & 31, hh = lane >> 5;
    const float negB2 = ((const float*)(p.ws + OFF_BOUND))[0];
    constexpr int NQB = S_ / 256, NPAIR = B_ * 8 * (NQB / 2);
    LAS float* lsum = (LAS float*)(lds + 2 * BUF_B);
    for (int pair = blockIdx.x; pair < NPAIR; pair += gridDim.x) {
        int bh = pair / (NQB / 2), jj = pair % (NQB / 2);
        if (gridDim.x == 256 && NPAIR == 256 && NQB == 16) { const int x = pair & 7, j = pair >> 3; bh = 4 * x + (j >> 3); jj = j & 7; }
        for (int half = 0; half < 2; ++half) {
            const int qb = half ? NQB - 1 - jj : jj;
            const int q0 = qb * 256, NT = 4 * (qb + 1);
            const int qw0 = q0 + 32 * w, qg = qw0 + r;
            const bf16_t* Kg = K0 + (size_t)bh * S_ * 96;
            const bf16_t* Vg = V0 + (size_t)bh * 64 * S_;
            bf16x8_t qf[6];
            {
                const bf16_t* Qp = Q0 + ((size_t)((bh >> 3) * S_ + qg)) * 768 + (bh & 7) * 96;
                const float* gq = p.in[I_QNQ]; const float* rope = (const float*)(p.ws + OFF_ROPE);
                float x[6][8]; float ss = 0.f;
#pragma unroll
                for (int ks = 0; ks < 6; ++ks) { const bf16x8_t raw = *(const bf16x8_t*)(Qp + 16 * ks + 8 * hh);
#pragma unroll
                    for (int j = 0; j < 8; ++j) { x[ks][j] = bf2f((bf16_t)raw[j]); ss += x[ks][j] * x[ks][j]; } }
                ss += __shfl_xor(ss, 32);
                const float rstd = 1.0f / sqrtf(ss * (1.0f / 96.0f) + EPS_), sc = 0.10206207261596577f * LOG2E_;
#pragma unroll
                for (int ks = 0; ks < 6; ++ks)
#pragma unroll
                    for (int j = 0; j < 8; ++j) x[ks][j] *= rstd * gq[16 * ks + 8 * hh + j];
#pragma unroll
                for (int j = 0; j < 8; ++j) { const float cs = rope[(size_t)qg * 16 + 8 * hh + j], sn = rope[(size_t)(S_ + qg) * 16 + 8 * hh + j];
                    const float x1 = x[4][j], x2 = x[5][j]; x[4][j] = x1 * cs - x2 * sn; x[5][j] = x2 * cs + x1 * sn; }
#pragma unroll
                for (int ks = 0; ks < 6; ++ks) { u32x4_t w_; w_.x = cvtpk(x[ks][0] * sc, x[ks][1] * sc); w_.y = cvtpk(x[ks][2] * sc, x[ks][3] * sc); w_.z = cvtpk(x[ks][4] * sc, x[ks][5] * sc); w_.w = cvtpk(x[ks][6] * sc, x[ks][7] * sc);
                    qf[ks] = __builtin_bit_cast(bf16x8_t, w_); }
            }
            f32x16 o0, o1;
#pragma unroll
            for (int i = 0; i < 16; ++i) { o0[i] = 0.f; o1[i] = 0.f; }
            float l = 0.f;
            const int kc0 = tid, kc1 = tid + 512;
            const int kdst0 = (kc0 / 12) * KROW + (kc0 % 12) * 16, kdst1 = (kc1 / 12) * KROW + (kc1 % 12) * 16;
            const int vrow = tid >> 3, vch = tid & 7, vdst = KT_B + vrow * VROW + vch * 16;
            u32x4_t ak0, ak1, av, bk0, bk1, bv, ck0, ck1, cv_;
            ak1 = bk1 = ck1 = (u32x4_t){0u, 0u, 0u, 0u};
#define MLA_LOAD(T, RK0, RK1, RV) do { const unsigned char* kg_ = (const unsigned char*)Kg + (size_t)(T) * 64 * 192; RK0 = *(const u32x4_t*)(kg_ + (size_t)kc0 * 16); \
                if (tid < 256) RK1 = *(const u32x4_t*)(kg_ + (size_t)kc1 * 16); RV = *(const u32x4_t*)(Vg + (size_t)vrow * S_ + (T) * 64 + vch * 8); } while (0)
#define MLA_STORE(BUF, RK0, RK1, RV) do { *(LAS u32x4_t*)(lds + (BUF) + kdst0) = RK0; if (tid < 256) *(LAS u32x4_t*)(lds + (BUF) + kdst1) = RK1; *(LAS u32x4_t*)(lds + (BUF) + vdst) = RV; } while (0)
#define MLA_STEP(WK0, WK1, WV, IK0, IK1, IV) { if (kt + 3 < NT) MLA_LOAD(kt + 3, IK0, IK1, IV); \
                if (64 * kt <= qw0 + 31) mla_tile(lds, cur, kt, qf, o0, o1, l, negB2, qw0, qg, r, hh); \
                if (kt + 1 < NT) MLA_STORE(nxt, WK0, WK1, WV); __syncthreads(); if (++kt >= NT) break; cur = nxt; nxt = BUF_B - cur; }
            MLA_LOAD(0, ak0, ak1, av); MLA_STORE(0, ak0, ak1, av);
            if (NT > 1) MLA_LOAD(1, ak0, ak1, av);
            if (NT > 2) MLA_LOAD(2, bk0, bk1, bv);
            __syncthreads();
            int kt = 0, cur = 0, nxt = BUF_B;
            for (;;) {
                MLA_STEP(ak0, ak1, av, ck0, ck1, cv_)
                MLA_STEP(bk0, bk1, bv, ak0, ak1, av)
                MLA_STEP(ck0, ck1, cv_, bk0, bk1, bv)
            }
#undef MLA_STEP
#undef MLA_LOAD
#undef MLA_STORE
            l += __shfl_xor(l, 32);
            if (hh == 0) lsum[w * 32 + r] = l;
            __builtin_amdgcn_s_waitcnt(0xc07f);
            __builtin_amdgcn_wave_barrier();
            const int b = bh >> 3, h = bh & 7;
#pragma unroll
            for (int i = 0; i < 16; ++i) {
                const int qr = crow(i, hh); const float inv = 1.0f / lsum[w * 32 + qr];
                bf16_t* dst = cat + ((size_t)b * S_ + qw0 + qr) * 1024 + 512 + h * 64 + r;
                dst[0] = f2bf(o0[i] * inv); dst[32] = f2bf(o1[i] * inv);
            }
        }
    }
}
#endif

DEVFN void ph_norm(const Params& p, const float* gain) { norm_rows_bf16<1024>(p.out, 1024, gain, (bf16_t*)(p.ws + OFF_XN), 1024, T_); }

DEVFN void ph_l1_prep(const Params& p) {
    const float* z1 = (const float*)(p.ws + OFF_BIG);
    bf16_t* Qn = (bf16_t*)(p.ws + OFF_QN);
    bf16_t* KV = (bf16_t*)(p.ws + SM_KV);
    float* gate = (float*)(p.ws + SM_GATE);
    const float *gq = p.in[I_NQN], *gk = p.in[I_NKN];
    for (int it = GTID; it < T_ * 28; it += GSZ) {
        const int t = it % T_, u = it / T_; const int b = t / S_, s = t % S_;
        float v[64]; float ss = 0.f;
        const float* src = z1 + (size_t)t * NSAIN_P + u * 64;
#pragma unroll
        for (int i = 0; i < 64; ++i) { v[i] = src[i]; ss += v[i] * v[i]; }
        const float rstd = 1.0f / sqrtf(ss / 64.0f + EPS_);
        bf16_t* dst; const float* g = nullptr; float sc = 1.0f; size_t estride = 1;
        if (u < 16) { dst = Qn + ((size_t)(b * 16 + u) * S_ + s) * 64; g = gq; sc = 0.125f * LOG2E_; }
        else { const int x = (u - 16) >> 1, gg = (u - 16) & 1; dst = KV + (size_t)x * (KVSZ / 2) + ((size_t)(b * 2 + gg) * S_ + s) * 64;
               if (x == 2) g = gk + 64; else if (x == 4) g = gk + 128;
               if (x == 5) { dst = KV + (size_t)x * (KVSZ / 2) + (size_t)(b * 2 + gg) * 64 * S_ + vperm16(s); estride = S_; }
               if (x == 3) { dst = KV + (size_t)x * (KVSZ / 2) + (size_t)(b * 2 + gg) * 64 * S_ + vperm32(s); estride = S_; } }
#pragma unroll
        for (int i = 0; i < 64; ++i) dst[(size_t)i * estride] = f2bf(g ? v[i] * rstd * g[i] * sc : v[i]);
    }
    for (int it = GTID; it < T_ * 48; it += GSZ) gate[it] = sigmoidf_(z1[(size_t)(it / 48) * NSAIN_P + 1792 + it % 48]);
}

DEVFN void ph_l1_ck(const Params& p) {
#ifndef CPU_EMU
    {
        typedef __attribute__((address_space(3))) float lds_f;
        const float* part = (const float*)(p.ws + OFF_BIG + (size_t)T_ * 2048); const float* cb = (const float*)(p.ws + OFF_CBIAS);
        bf16_t* CK = (bf16_t*)(p.ws + SM_CK); bf16_t* CV = (bf16_t*)(p.ws + SM_CV);
        const int tid = TIDX, lane = tid & 63, wv = tid >> 6, gw = (int)(blockIdx.x * 8 + wv), nw = (int)gridDim.x * 8;
        lds_f* hs = (lds_f*)((__attribute__((address_space(3))) unsigned char*)g_lds) + wv * 256;
        for (int it = gw; it < MCMP * 2; it += nw) {
            const int row = it % MCMP, isv = it / MCMP;
            if ((row % NCP_) >= NC_) continue;
            f32x4 hsum = *(const f32x4*)(cb + isv * 256 + lane * 4);
#pragma unroll
            for (int sl = 0; sl < 8; ++sl) hsum += *(const f32x4*)(part + ((size_t)(isv * 8 + sl) * MCMP + row) * 256 + lane * 4);
#pragma unroll
            for (int j = 0; j < 4; ++j) hs[lane * 4 + j] = gelu_tanh(hsum[j]);
            asm volatile("s_waitcnt lgkmcnt(0)" ::: "memory");
            const float* w2 = p.in[isv ? I_C2V : I_C2K];
            float acc = 0.f;
#pragma unroll 32
            for (int j = 0; j < 256; ++j) acc += hs[j] * w2[j * 64 + lane];
            if (!isv) { float ss = acc * acc;
#pragma unroll
                for (int o = 1; o < 64; o <<= 1) ss += __shfl_xor(ss, o);
                const float rstd = 1.0f / sqrtf(ss / 64.0f + EPS_);
                CK[(size_t)row * 64 + lane] = f2bf(acc * rstd * p.in[I_NKN][lane]);
            } else CV[(size_t)(row / NCP_) * 64 * NCP_ + (size_t)lane * NCP_ + vperm16(row % NCP_)] = f2bf(acc);
            asm volatile("s_waitcnt lgkmcnt(0)" ::: "memory");
        }
        return;
    }
#endif
    const bf16_t* HK = (const bf16_t*)(p.ws + SM_HK); const bf16_t* HV = (const bf16_t*)(p.ws + SM_HV);
    bf16_t* CK = (bf16_t*)(p.ws + SM_CK); bf16_t* CV = (bf16_t*)(p.ws + SM_CV);
    for (int it = GTID; it < MCMP * 2; it += GSZ) {
        const int row = it % MCMP, isv = it / MCMP;
        if ((row % NCP_) >= NC_) continue;
        const bf16_t* hrow = (isv ? HV : HK) + (size_t)row * 256; const float* w2 = p.in[isv ? I_C2V : I_C2K];
        float acc[64];
#pragma unroll
        for (int e = 0; e < 64; ++e) acc[e] = 0.f;
        for (int j = 0; j < 256; ++j) { const float hv = bf2f(hrow[j]);
#pragma unroll
            for (int e = 0; e < 64; ++e) acc[e] += hv * w2[j * 64 + e]; }
        bf16_t* dst = (isv ? CV : CK) + (size_t)row * 64;
        if (!isv) { float ss = 0.f;
#pragma unroll
            for (int e = 0; e < 64; ++e) ss += acc[e] * acc[e];
            const float rstd = 1.0f / sqrtf(ss / 64.0f + EPS_);
#pragma unroll
            for (int e = 0; e < 64; ++e) dst[e] = f2bf(acc[e] * rstd * p.in[I_NKN][e]);
        } else {
            bf16_t* dt = CV + (size_t)(row / NCP_) * 64 * NCP_ + vperm16(row % NCP_);
#pragma unroll
            for (int e = 0; e < 64; ++e) dt[(size_t)e * NCP_] = f2bf(acc[e]);
        }
    }
}

DEVFN void ph_l1_cattn(const Params& p) {
    const bf16_t* Qn = (const bf16_t*)(p.ws + OFF_QN);
    const bf16_t* CK = (const bf16_t*)(p.ws + SM_CK); const bf16_t* CV = (const bf16_t*)(p.ws + SM_CV);
    const float* gate = (const float*)(p.ws + SM_GATE); const float* tab = p.in[I_RELB];
    float* stat = (float*)(p.ws + SM_STAT); float* acc_o = (float*)(p.ws + OFF_BIG);
    for (int it = GTID; it < T_ * 16; it += GSZ) {
        const int q = it % S_, bh = it / S_, b = bh >> 4, h = bh & 15, g = h >> 3;
        float qv[64], o[64];
        const bf16_t* qp = Qn + ((size_t)bh * S_ + q) * 64;
#pragma unroll
        for (int i = 0; i < 64; ++i) { qv[i] = bf2f(qp[i]); o[i] = 0.f; }
        int nvalid = q >= 31 ? (q - 31) / 16 + 1 : 0; if (nvalid > NC_) nvalid = NC_;
        float m = -1e30f, l = 0.f;
        for (int n = 0; n < nvalid; ++n) {
            const bf16_t* kp = CK + ((size_t)(b * 2 + g) * NCP_ + n) * 64; const bf16_t* vp = CV + (size_t)(b * 2 + g) * 64 * NCP_ + vperm16(n);
            float s = tab[t5_bucket(q - (16 * n + 31)) * 16 + h] * LOG2E_;
#pragma unroll
            for (int i = 0; i < 64; ++i) s += qv[i] * bf2f(kp[i]);
            if (s > m) { const float cr = exp2f(m - s); l *= cr;
#pragma unroll
                for (int i = 0; i < 64; ++i) o[i] *= cr;
                m = s; }
            const float pe = exp2f(s - m); l += pe;
#pragma unroll
            for (int i = 0; i < 64; ++i) o[i] += pe * bf2f(vp[(size_t)i * NCP_]);
        }
        stat[(size_t)it * 2] = m; stat[(size_t)it * 2 + 1] = l;
        const size_t t = (size_t)b * S_ + q;
        const float sc = nvalid > 0 ? gate[t * 48 + h * 3 + 0] / l : 0.f;
#pragma unroll
        for (int i = 0; i < 64; ++i) acc_o[t * 1024 + h * 64 + i] = o[i] * sc;
    }
}

DEVFN void ph_l1_imp(const Params& p) {
    const bf16_t* Qn = (const bf16_t*)(p.ws + OFF_QN);
    const bf16_t* CK = (const bf16_t*)(p.ws + SM_CK);
    const float* stat = (const float*)(p.ws + SM_STAT); const float* tab = p.in[I_RELB];
    float* imp = (float*)(p.ws + SM_IMP);
    for (int it = GTID; it < T_ * 2 * NSEL_; it += GSZ) {
        const int mb = it % NSEL_, q = (it / NSEL_) % S_, bg = it / (NSEL_ * S_), b = bg >> 1, g = bg & 1;
        const int cur = q >> 6;
        float score;
        if (mb > cur) score = -1.0f;
        else if (mb == 0 || mb == cur || mb == cur - 1) score = 1e4f;
        else {
            int nvalid = q >= 31 ? (q - 31) / 16 + 1 : 0; if (nvalid > NC_) nvalid = NC_;
            score = 0.f;
            for (int hh = 0; hh < 8; ++hh) {
                const int h = g * 8 + hh; const size_t si = ((size_t)(b * 16 + h) * S_ + q);
                const float m = stat[si * 2], rl = 1.0f / stat[si * 2 + 1];
                const bf16_t* qp = Qn + si * 64;
                for (int dn = -1; dn <= 3; ++dn) {
                    const int n = 4 * mb + dn; if (n < 0 || n >= nvalid) continue;
                    const bf16_t* kp = CK + ((size_t)bg * NCP_ + n) * 64;
                    float s = tab[t5_bucket(q - (16 * n + 31)) * 16 + h] * LOG2E_;
                    for (int i = 0; i < 64; ++i) s += bf2f(qp[i]) * bf2f(kp[i]);
                    score += ((dn == -1 || dn == 3) ? 0.5f : 1.0f) * exp2f(s - m) * rl;
                }
            }
        }
        imp[it] = score;
    }
}

DEVFN void ph_l1_topk(const Params& p) {
    const float* imp = (const float*)(p.ws + SM_IMP); unsigned long long* selm = (unsigned long long*)(p.ws + SM_IDX);
    for (int it = GTID; it < T_ * 2; it += GSZ) {
        float sv[8]; int si[8];
#pragma unroll
        for (int j = 0; j < 8; ++j) { sv[j] = -2.0f; si[j] = -1; }
        for (int mb = 0; mb < NSEL_; ++mb) {
            float v = imp[(size_t)it * NSEL_ + mb]; int vi = mb;
            if (v < 0.f) continue;
            bool ins = false;
#pragma unroll
            for (int j = 0; j < 8; ++j) { ins = ins || (v > sv[j]); if (ins) { const float tv = sv[j]; const int ti = si[j]; sv[j] = v; si[j] = vi; v = tv; vi = ti; } }
        }
        unsigned long long mask = 0ull;
#pragma unroll
        for (int j = 0; j < 8; ++j) if (si[j] >= 0) mask |= 1ull << si[j];
        selm[it] = mask;
    }
}

template <bool DO_WIN>
DEVFN void ph_l1_selwin(const Params& p) {
    const bf16_t* Qn = (const bf16_t*)(p.ws + OFF_QN);
    const bf16_t* KV = (const bf16_t*)(p.ws + SM_KV);
    const bf16_t *KS = KV + 2 * (KVSZ / 2), *VS = KV + 3 * (KVSZ / 2), *KW = KV + 4 * (KVSZ / 2), *VW = KV + 5 * (KVSZ / 2);
    const float* gate = (const float*)(p.ws + SM_GATE); const float* tab = p.in[I_RELB];
    const unsigned long long* selm = (const unsigned long long*)(p.ws + SM_IDX);
    float* acc_o = (float*)(p.ws + OFF_BIG); bf16_t* nsa_o = (bf16_t*)(p.ws + OFF_BIG + (size_t)T_ * 4096);
    for (int it = GTID; it < T_ * 16; it += GSZ) {
        const int q = it % S_, bh = it / S_, b = bh >> 4, h = bh & 15, g = h >> 3, bg = b * 2 + g;
        const size_t t = (size_t)b * S_ + q;
        float qv[64], o[64];
        const bf16_t* qp = Qn + ((size_t)bh * S_ + q) * 64;
#pragma unroll
        for (int i = 0; i < 64; ++i) qv[i] = bf2f(qp[i]);
        for (int br = 0; br < (DO_WIN ? 2 : 1); ++br) {
#pragma unroll
            for (int i = 0; i < 64; ++i) o[i] = 0.f;
            float m = -1e30f, l = 0.f;
            const bf16_t* Kb = (br ? KW : KS) + (size_t)bg * S_ * 64; const bf16_t* Vb = (br ? VW : VS) + (size_t)bg * S_ * 64;
            const int nseg = br ? 1 : (q >> 6) + 1;
            const unsigned long long mask = selm[(size_t)bg * S_ + q];
            for (int sg = 0; sg < nseg; ++sg) {
                int k0, k1;
                if (br) { k0 = q - 511 > 0 ? q - 511 : 0; k1 = q; }
                else { if (!((mask >> sg) & 1ull)) continue; k0 = sg * 64; k1 = k0 + 63 < q ? k0 + 63 : q; }
                for (int kpos = k0; kpos <= k1; ++kpos) {
                    const bf16_t* kp = Kb + (size_t)kpos * 64;
                    const bf16_t* vp = br ? Vb + vperm16(kpos) : Vb + vperm32(kpos); const size_t vst = (size_t)S_;
                    float s = tab[t5_bucket(q - kpos) * 16 + h] * LOG2E_;
#pragma unroll
                    for (int i = 0; i < 64; ++i) s += qv[i] * bf2f(kp[i]);
                    if (s > m) { const float cr = exp2f(m - s); l *= cr;
#pragma unroll
                        for (int i = 0; i < 64; ++i) o[i] *= cr;
                        m = s; }
                    const float pe = exp2f(s - m); l += pe;
#pragma unroll
                    for (int i = 0; i < 64; ++i) o[i] += pe * bf2f(vp[(size_t)i * vst]);
                }
            }
            const float sc = gate[t * 48 + h * 3 + 1 + br] / l;
            if (br == 0) {
#pragma unroll
                for (int i = 0; i < 64; ++i) acc_o[t * 1024 + h * 64 + i] += o[i] * sc;
            } else {
#pragma unroll
                for (int i = 0; i < 64; ++i) nsa_o[t * 1024 + h * 64 + i] = f2bf(acc_o[t * 1024 + h * 64 + i] + o[i] * sc);
            }
        }
    }
}

#ifndef CPU_EMU
__device__ __forceinline__ bool nsa_unit(int k, int& bg, int& qt) {
    constexpr int NQT = S_ / 32;
    if (gridDim.x == 256 && NQT == 128 && B_ * 2 == 8) { if (k >= 4) return false; const int j = blockIdx.x >> 3; bg = blockIdx.x & 7;
        qt = (k == 0) ? j : (k == 1) ? 63 - j : (k == 2) ? 64 + j : 127 - j; return true; }
    const int unit = blockIdx.x + k * gridDim.x; if (unit >= B_ * 2 * NQT) return false; bg = unit / NQT; qt = unit % NQT; return true;
}
__device__ __forceinline__ void ph_l1_cmp_mfma(const Params& p) {
    constexpr int KROWB = 144, CK_B = 256 * KROWB, VROWB = 528, CV_B = 64 * VROWB, SLROW = 33, SLAB_B = 8 * 64 * SLROW * 4;
    constexpr int O_CK = 0, O_CV = CK_B, O_SLAB = O_CV + CV_B, O_BKT = O_SLAB + SLAB_B, O_TABL = O_BKT + 4096, O_RLS = O_TABL + 2048;
    static_assert(O_RLS + 1024 <= 147456, "LDS budget");
    LAS unsigned char* lds = (LAS unsigned char*)g_lds;
    LAS float* slab = (LAS float*)(lds + O_SLAB);
    LAS unsigned char* bkt = lds + O_BKT;
    LAS float* tabl = (LAS float*)(lds + O_TABL);
    LAS float* rls = (LAS float*)(lds + O_RLS);
    const bf16_t* Qn = (const bf16_t*)(p.ws + OFF_QN);
    const bf16_t* CK = (const bf16_t*)(p.ws + SM_CK); const bf16_t* CV = (const bf16_t*)(p.ws + SM_CV);
    const float* gate = (const float*)(p.ws + SM_GATE); const float* tab = p.in[I_RELB];
    bf16_t* acc_o = (bf16_t*)(p.ws + OFF_BIG);
    unsigned long long* selm = (unsigned long long*)(p.ws + SM_IDX);
    const int tid = TIDX, lane = tid & 63, w = __builtin_amdgcn_readfirstlane(tid >> 6), r = lane & 31, hh = lane >> 5;
    const float negB2 = ((const float*)(p.ws + OFF_BOUND))[1];
    for (int i = tid; i < 1024; i += 512) ((LAS unsigned*)bkt)[i] = ((const unsigned*)(p.ws + OFF_BKT))[i];
    for (int i = tid; i < 512; i += 512) tabl[i] = tab[i] * LOG2E_;
    __syncthreads();
    int staged_bg = -1;
    for (int uk = 0;; ++uk) {
        int bg, qt;
        if (gridDim.x == 256 && S_ == 4096 && B_ * 2 == 8) {
            if (uk >= 4) break; const int j = blockIdx.x >> 3; bg = blockIdx.x & 7; qt = (uk == 0) ? 2 * j : (uk == 1) ? 2 * j + 1 : (uk == 2) ? 126 - 2 * j : 127 - 2 * j; }
        else if (!nsa_unit(uk, bg, qt)) break;
        const int q0 = qt * 32, b = bg >> 1, g = bg & 1, h = g * 8 + w;
        const int qg = q0 + r;
        if (bg != staged_bg) { staged_bg = bg;
          const unsigned char* ckg = (const unsigned char*)(CK + (size_t)bg * NCP_ * 64); const unsigned char* cvg = (const unsigned char*)(CV + (size_t)bg * 64 * NCP_);
#pragma unroll
          for (int j = 0; j < 4; ++j) { const int c = tid + 512 * j;
              *(LAS u32x4_t*)(lds + O_CK + (c >> 3) * KROWB + (c & 7) * 16) = *(const u32x4_t*)(ckg + (size_t)c * 16);
              *(LAS u32x4_t*)(lds + O_CV + (c >> 5) * VROWB + (c & 31) * 16) = *(const u32x4_t*)(cvg + (size_t)c * 16); } }
        for (int i = tid; i < 8 * 64 * SLROW; i += 512) slab[i] = 0.f;
        __syncthreads();
        bf16x8_t qf[4];
        { const bf16_t* Qp = Qn + ((size_t)(b * 16 + h) * S_ + qg) * 64;
#pragma unroll
          for (int ks = 0; ks < 4; ++ks) qf[ks] = *(const bf16x8_t*)(Qp + 16 * ks + 8 * hh); }
        f32x16 o0, o1;
#pragma unroll
        for (int i = 0; i < 16; ++i) { o0[i] = 0.f; o1[i] = 0.f; }
        float l = 0.f;
        const int qmax = q0 + 31; const int nvmax = qmax >= 31 ? (qmax - 31) / 16 + 1 : 0;
        const int NT = (nvmax + 63) >> 6;
        LAS float* myslab = slab + w * 64 * SLROW;
        for (int kt = 0; kt < NT; ++kt) {
            int hq = hh, rq = r; asm volatile("" : "+v"(hq), "+v"(rq));
            f32x16 s0, s1;
#pragma unroll
            for (int i = 0; i < 16; ++i) { s0[i] = negB2; s1[i] = negB2; }
#pragma unroll
            for (int ks = 0; ks < 4; ++ks) {
                const bf16x8_t k0 = *(const LAS bf16x8_t*)(lds + O_CK + (64 * kt + r) * KROWB + (16 * ks + 8 * hh) * 2);
                const bf16x8_t k1 = *(const LAS bf16x8_t*)(lds + O_CK + (64 * kt + 32 + r) * KROWB + (16 * ks + 8 * hh) * 2);
                s0 = __builtin_amdgcn_mfma_f32_32x32x16_bf16(k0, qf[ks], s0, 0, 0, 0);
                s1 = __builtin_amdgcn_mfma_f32_32x32x16_bf16(k1, qf[ks], s1, 0, 0, 0);
            }
            float ls = 0.f;
            const int dmin = q0 - (16 * (64 * kt + 63) + 31);
            if (dmin >= 0 && bkt[dmin] == 31) {
                const float bf_ = tabl[31 * 16 + h];
#pragma unroll
                for (int i = 0; i < 16; ++i) { const float p0 = __builtin_amdgcn_exp2f(s0[i] + bf_), p1 = __builtin_amdgcn_exp2f(s1[i] + bf_); s0[i] = p0; s1[i] = p1; ls += p0 + p1; }
            } else {
#pragma unroll
            for (int i = 0; i < 16; ++i) {
                const int n0 = 64 * kt + crow(i, hq);
                const int d0 = (q0 + rq) - (16 * n0 + 31), d1 = d0 - 512;
                const float b0 = tabl[(int)bkt[d0 & 4095] * 16 + h], b1 = tabl[(int)bkt[d1 & 4095] * 16 + h];
                float p0 = __builtin_amdgcn_exp2f(s0[i] + b0), p1 = __builtin_amdgcn_exp2f(s1[i] + b1);
                if (d0 < 0) p0 = 0.f;
                if (d1 < 0) p1 = 0.f;
                s0[i] = p0; s1[i] = p1; ls += p0 + p1;
                if ((i & 3) == 3) asm volatile("" ::: "memory");
            }
            }
            l += ls;
#pragma unroll
            for (int a = 0; a < 4; ++a) {
                const int m0 = 16 * kt + 2 * a + hq, m1 = m0 + 8;
                const float c0 = 0.5f * s0[4 * a + 3], c1 = 0.5f * s1[4 * a + 3];
                const float A0 = s0[4 * a] + s0[4 * a + 1] + s0[4 * a + 2] + c0, A1 = s1[4 * a] + s1[4 * a + 1] + s1[4 * a + 2] + c1;
                { LAS float* s_ = myslab + m0 * SLROW + rq; *s_ = *s_ + A0; }
                { LAS float* s_ = myslab + m1 * SLROW + rq; *s_ = *s_ + A1; }
                asm volatile("s_waitcnt lgkmcnt(0)" ::: "memory");
                { LAS float* s_ = myslab + (m0 + 1) * SLROW + rq; *s_ = *s_ + c0; }
                if (m1 + 1 < 64) { LAS float* s_ = myslab + (m1 + 1) * SLROW + rq; *s_ = *s_ + c1; }
                asm volatile("s_waitcnt lgkmcnt(0)" ::: "memory");
            }
            const bf16x8_t pa = pack8(s0, 0), pb = pack8(s0, 8), pc = pack8(s1, 0), pd = pack8(s1, 8);
            const LAS unsigned char* vb = lds + O_CV + r * VROWB + (64 * kt + 8 * hh) * 2;
#define PV_STEP(PF, SP) do { const bf16x8_t v0 = *(const LAS bf16x8_t*)(vb + (SP) * 32); const bf16x8_t v1 = *(const LAS bf16x8_t*)(vb + 32 * VROWB + (SP) * 32); \
                o0 = __builtin_amdgcn_mfma_f32_32x32x16_bf16(PF, v0, o0, 0, 0, 0); o1 = __builtin_amdgcn_mfma_f32_32x32x16_bf16(PF, v1, o1, 0, 0, 0); } while (0)
            PV_STEP(pa, 0); PV_STEP(pb, 1); PV_STEP(pc, 2); PV_STEP(pd, 3);
#undef PV_STEP
        }
        l += __shfl_xor(l, 32);
        if (hh == 0) rls[w * 32 + r] = l > 0.f ? 1.0f / l : 0.f;
        __syncthreads();
        {
            float gsc[16];
#pragma unroll
            for (int i = 0; i < 16; ++i) { const int qr = crow(i, hh); gsc[i] = gate[((size_t)b * S_ + q0 + qr) * 48 + h * 3 + 0] * rls[w * 32 + qr]; }
            float pa0[16], pa1[16];
#pragma unroll
            for (int i = 0; i < 16; ++i) { const size_t o = ((size_t)b * S_ + q0 + crow(i, hh)) * 1024 + h * 64 + r; pa0[i] = bf2f(acc_o[o]); pa1[i] = bf2f(acc_o[o + 32]); }
#pragma unroll
            for (int i = 0; i < 16; ++i) { const size_t o = ((size_t)b * S_ + q0 + crow(i, hh)) * 1024 + h * 64 + r; acc_o[o] = f2bf(pa0[i] + o0[i] * gsc[i]); acc_o[o + 32] = f2bf(pa1[i] + o1[i] * gsc[i]); }
        }
#pragma unroll
        for (int j = 0; j < 4; ++j) {
            int m = lane; asm volatile("" : "+v"(m));
            const int qi = 4 * w + j, q = q0 + qi, cur = q >> 6;
            float imp = 0.f;
#pragma unroll
            for (int ww = 0; ww < 8; ++ww) imp += slab[(ww * 64 + m) * SLROW + qi] * rls[ww * 32 + qi];
            const bool valid = m <= cur, forced = (m == 0) || (m == cur) || (m == cur - 1);
            const float score = !valid ? -1.0f : (forced ? 1e4f : imp);
            int rank = 0;
#pragma unroll 8
            for (int mm = 0; mm < 64; ++mm) { const float sj = __builtin_bit_cast(float, __builtin_amdgcn_readlane(__builtin_bit_cast(int, score), mm)); rank += (sj > score || (sj == score && mm < m)) ? 1 : 0; }
            const unsigned long long mask = __ballot(valid && rank < 8);
            if (lane == 0) selm[(size_t)bg * S_ + q] = mask;
        }
        __syncthreads();
    }
}
#endif

#ifndef CPU_EMU
typedef float f32x4_t __attribute__((ext_vector_type(4)));
constexpr int SEL_NPP = 4, SEL_NQW = 2 * SEL_NPP, SEL_UQ = 8 * SEL_NQW;
__device__ __forceinline__ void sel_block(LAS unsigned char* lds, int cb, int m, const unsigned long long (&mk4)[SEL_NQW], const bf16x8_t (&qf)[SEL_NPP][2], f32x4_t (&oacc)[SEL_NPP][4], float (&lsum)[SEL_NPP],
                                          float negB2, int q0, int w, int g, int hd, int kg, const LAS unsigned char* bkt, const LAS float* tabl) {
    constexpr int ROWB = 160, TILE_B = 64 * ROWB;
#pragma unroll
    for (int pp = 0; pp < SEL_NPP; ++pp) {
        const bool selA = (mk4[2 * pp] >> m) & 1ull, selB = (mk4[2 * pp + 1] >> m) & 1ull;
        if (selA || selB) {
            const int qA = q0 + SEL_NQW * w + 2 * pp, q = qA + (hd >> 3);
            const bool mine = (hd & 8) ? selB : selA;
            f32x4_t st[4];
#pragma unroll
            for (int t16 = 0; t16 < 4; ++t16) {
                f32x4_t a = (f32x4_t){negB2, negB2, negB2, negB2};
#pragma unroll
                for (int ks = 0; ks < 2; ++ks) {
                    const bf16x8_t kf = *(const LAS bf16x8_t*)(lds + cb + (16 * t16 + hd) * ROWB + (32 * ks + 8 * kg) * 2);
                    a = __builtin_amdgcn_mfma_f32_16x16x32_bf16(kf, qf[pp][ks], a, 0, 0, 0);
                }
                st[t16] = a;
            }
            float ls = 0.f;
            const int dmin = qA - (64 * m + 63);
            if (dmin >= 0 && bkt[dmin] == 31) {
                const float bf_ = tabl[31 * 16 + g * 8 + (hd & 7)];
#pragma unroll
                for (int t16 = 0; t16 < 4; ++t16)
#pragma unroll
                    for (int rg = 0; rg < 4; ++rg) { float pe = __builtin_amdgcn_exp2f(st[t16][rg] + bf_); if (!mine) pe = 0.f; st[t16][rg] = pe; ls += pe; }
            } else {
#pragma unroll
                for (int t16 = 0; t16 < 4; ++t16)
#pragma unroll
                    for (int rg = 0; rg < 4; ++rg) {
                        const int d = q - (64 * m + 16 * t16 + 4 * kg + rg);
                        const float bb = tabl[(int)bkt[d & 4095] * 16 + g * 8 + (hd & 7)];
                        float pe = __builtin_amdgcn_exp2f(st[t16][rg] + bb);
                        if (d < 0 || !mine) pe = 0.f;
                        st[t16][rg] = pe; ls += pe;
                    }
            }
            lsum[pp] += ls;
#pragma unroll
            for (int kp = 0; kp < 2; ++kp) {
                u32x4_t pw; pw.x = cvtpk(st[2 * kp][0], st[2 * kp][1]); pw.y = cvtpk(st[2 * kp][2], st[2 * kp][3]);
                pw.z = cvtpk(st[2 * kp + 1][0], st[2 * kp + 1][1]); pw.w = cvtpk(st[2 * kp + 1][2], st[2 * kp + 1][3]);
                const bf16x8_t pf = __builtin_bit_cast(bf16x8_t, pw);
#pragma unroll
                for (int dt = 0; dt < 4; ++dt) {
                    const bf16x8_t vf = *(const LAS bf16x8_t*)(lds + cb + TILE_B + (16 * dt + hd) * ROWB + (32 * kp + 8 * kg) * 2);
                    oacc[pp][dt] = __builtin_amdgcn_mfma_f32_16x16x32_bf16(vf, pf, oacc[pp][dt], 0, 0, 0);
                }
            }
        }
    }
}


__device__ __forceinline__ void ph_l1_sel_mfma(const Params& p) {
    constexpr int ROWB = 160, TILE_B = 64 * ROWB, BLK_B = 2 * TILE_B, BUF_B = 2 * BLK_B;
    constexpr int O_BKT = 2 * BUF_B, O_TABL = O_BKT + 4096;
    LAS unsigned char* lds = (LAS unsigned char*)g_lds;
    LAS unsigned char* bkt = lds + O_BKT; LAS float* tabl = (LAS float*)(lds + O_TABL);
    const bf16_t* Qn = (const bf16_t*)(p.ws + OFF_QN);
    const bf16_t* KV = (const bf16_t*)(p.ws + SM_KV);
    const bf16_t *KS = KV + 2 * (KVSZ / 2), *VS = KV + 3 * (KVSZ / 2);
    const float* gate = (const float*)(p.ws + SM_GATE); const float* tab = p.in[I_RELB];
    const unsigned long long* selm = (const unsigned long long*)(p.ws + SM_IDX);
    const bf16_t* acc_o = (const bf16_t*)(p.ws + OFF_BIG); bf16_t* nsa_o = (bf16_t*)(p.ws + OFF_BIG + (size_t)T_ * 4096);
    const int tid = TIDX, lane = tid & 63, w = __builtin_amdgcn_readfirstlane(tid >> 6), hd = lane & 15, kg = lane >> 4;
    const float negB2 = ((const float*)(p.ws + OFF_BOUND))[2];
    for (int i = tid; i < 1024; i += 512) ((LAS unsigned*)bkt)[i] = ((const unsigned*)(p.ws + OFF_BKT))[i];
    for (int i = tid; i < 512; i += 512) tabl[i] = tab[i] * LOG2E_;
    __syncthreads();
    for (int uk = 0;; ++uk) {
        constexpr int NU = S_ / SEL_UQ;
        int bg, qt;
        if (gridDim.x == 256 && NU == 64 && B_ * 2 == 8) { if (uk >= 2) break; const int j = blockIdx.x >> 3; bg = blockIdx.x & 7; qt = uk ? NU - 1 - j : j; }
        else { const int unit = blockIdx.x + uk * gridDim.x; if (unit >= B_ * 2 * NU) break; bg = unit / NU; qt = unit % NU; }
        const int q0 = qt * SEL_UQ, b = bg >> 1, g = bg & 1, cur = q0 >> 6;
        unsigned long long U = 0ull;
        for (int j = 0; j < SEL_UQ; ++j) U |= __hip_atomic_load(selm + (size_t)bg * S_ + q0 + j, __ATOMIC_RELAXED, __HIP_MEMORY_SCOPE_AGENT);
        unsigned long long mk4[SEL_NQW];
#pragma unroll
        for (int j = 0; j < SEL_NQW; ++j) { const unsigned long long v = __hip_atomic_load(selm + (size_t)bg * S_ + q0 + SEL_NQW * w + j, __ATOMIC_RELAXED, __HIP_MEMORY_SCOPE_AGENT);
            mk4[j] = ((unsigned long long)(unsigned)__builtin_amdgcn_readfirstlane((unsigned)(v >> 32)) << 32) | (unsigned long long)(unsigned)__builtin_amdgcn_readfirstlane((unsigned)v); }
        U = ((unsigned long long)(unsigned)__builtin_amdgcn_readfirstlane((unsigned)(U >> 32)) << 32) | (unsigned long long)(unsigned)__builtin_amdgcn_readfirstlane((unsigned)U);
        bf16x8_t qf[SEL_NPP][2];
#pragma unroll
        for (int pp = 0; pp < SEL_NPP; ++pp)
#pragma unroll
            for (int ks = 0; ks < 2; ++ks)
                qf[pp][ks] = *(const bf16x8_t*)(Qn + ((size_t)(b * 16 + g * 8 + (hd & 7)) * S_ + q0 + SEL_NQW * w + 2 * pp + (hd >> 3)) * 64 + 32 * ks + 8 * kg);
        f32x4_t oacc[SEL_NPP][4]; float lsum[SEL_NPP];
#pragma unroll
        for (int pp = 0; pp < SEL_NPP; ++pp) { lsum[pp] = 0.f;
#pragma unroll
            for (int dt = 0; dt < 4; ++dt) oacc[pp][dt] = (f32x4_t){0.f, 0.f, 0.f, 0.f}; }
        const bf16_t* Kg = KS + (size_t)bg * S_ * 64;
        const bf16_t* Vg = VS + (size_t)bg * 64 * S_;
        const int srow = tid >> 3, sch = tid & 7, kdst = srow * ROWB + sch * 16, vdst = TILE_B + kdst;
        u32x4_t a0, a1, a2, a3, b0_, b1_, b2_, b3_;
        int ia0 = 0, ia1 = -1, ib0 = 0, ib1 = -1;
        unsigned long long rem = U;
#define SEL_NEXT(I0, I1) do { I0 = __builtin_ctzll(rem); rem &= rem - 1; I1 = -1; if (rem) { I1 = __builtin_ctzll(rem); rem &= rem - 1; } } while (0)
#define SEL_LOAD(I0, I1, R0, R1, R2, R3) do { const int i1_ = (I1) < 0 ? (I0) : (I1); GLD16(R0, Kg + (size_t)((I0) * 64 + srow) * 64 + sch * 8); GLD16(R1, Vg + (size_t)srow * S_ + (I0) * 64 + sch * 8); \
            GLD16(R2, Kg + (size_t)(i1_ * 64 + srow) * 64 + sch * 8); GLD16(R3, Vg + (size_t)srow * S_ + i1_ * 64 + sch * 8); } while (0)
#define SEL_WAIT(N, R0, R1, R2, R3) asm volatile("s_waitcnt vmcnt(" #N ")" : "+v"(R0), "+v"(R1), "+v"(R2), "+v"(R3) :: "memory")
#define SEL_STORE(BUF, R0, R1, R2, R3) do { *(LAS u32x4_t*)(lds + (BUF) + kdst) = R0; *(LAS u32x4_t*)(lds + (BUF) + vdst) = R1; *(LAS u32x4_t*)(lds + (BUF) + BLK_B + kdst) = R2; *(LAS u32x4_t*)(lds + (BUF) + BLK_B + vdst) = R3; } while (0)
#pragma unroll
        for (int pp = 0; pp < SEL_NPP; ++pp) asm volatile("" : "+v"(qf[pp][0]), "+v"(qf[pp][1]));
        asm volatile("s_waitcnt vmcnt(0)" ::: "memory");
        int m0, m1; SEL_NEXT(m0, m1);
        SEL_LOAD(m0, m1, a0, a1, a2, a3); SEL_WAIT(0, a0, a1, a2, a3); SEL_STORE(0, a0, a1, a2, a3);
        bool has1 = rem != 0ull;
        if (has1) { SEL_NEXT(ia0, ia1); SEL_LOAD(ia0, ia1, a0, a1, a2, a3); }
        __syncthreads();
        int cb = 0, nb = BUF_B;
#define SEL_STEP(IW0, IW1, W0, W1, W2, W3, II0, II1, I0, I1, I2, I3) { const bool hasI = has1 && rem != 0ull; if (hasI) { SEL_NEXT(II0, II1); SEL_LOAD(II0, II1, I0, I1, I2, I3); } \
            sel_block(lds, cb, m0, mk4, qf, oacc, lsum, negB2, q0, w, g, hd, kg, bkt, tabl); \
            if (m1 >= 0) sel_block(lds, cb + BLK_B, m1, mk4, qf, oacc, lsum, negB2, q0, w, g, hd, kg, bkt, tabl); \
            if (has1) { if (hasI) SEL_WAIT(4, W0, W1, W2, W3); else SEL_WAIT(0, W0, W1, W2, W3); SEL_STORE(nb, W0, W1, W2, W3); } \
            __syncthreads(); if (!has1) break; m0 = IW0; m1 = IW1; has1 = hasI; cb = nb; nb = BUF_B - cb; }
        for (;;) {
            SEL_STEP(ia0, ia1, a0, a1, a2, a3, ib0, ib1, b0_, b1_, b2_, b3_)
            SEL_STEP(ib0, ib1, b0_, b1_, b2_, b3_, ia0, ia1, a0, a1, a2, a3)
        }
#undef SEL_STEP
#undef SEL_LOAD
#undef SEL_WAIT
#undef SEL_STORE
#undef SEL_NEXT
        {
            typedef unsigned u32x2s __attribute__((ext_vector_type(2)));
#pragma unroll
            for (int pp = 0; pp < SEL_NPP; ++pp) { float l = lsum[pp]; l += __shfl_xor(l, 16); l += __shfl_xor(l, 32);
                const size_t t = (size_t)b * S_ + q0 + SEL_NQW * w + 2 * pp + (hd >> 3); const int h = g * 8 + (hd & 7);
                const float sc = gate[t * 48 + h * 3 + 1] / l;
                u32x2s prev[4];
#pragma unroll
                for (int dt = 0; dt < 4; ++dt) { const unsigned long long pv_ = __hip_atomic_load((const unsigned long long*)(acc_o + t * 1024 + h * 64 + 16 * dt + 4 * kg), __ATOMIC_RELAXED, __HIP_MEMORY_SCOPE_AGENT); prev[dt] = (u32x2s){(unsigned)pv_, (unsigned)(pv_ >> 32)}; }
#pragma unroll
                for (int dt = 0; dt < 4; ++dt) { const f32x4_t a = oacc[pp][dt] * sc;
                    const float v0 = u2f(prev[dt].x << 16) + a[0], v1 = u2f(prev[dt].x & 0xffff0000u) + a[1], v2 = u2f(prev[dt].y << 16) + a[2], v3 = u2f(prev[dt].y & 0xffff0000u) + a[3];
                    *(u32x2s*)(nsa_o + t * 1024 + h * 64 + 16 * dt + 4 * kg) = (u32x2s){(unsigned)f2bf(v0) | ((unsigned)f2bf(v1) << 16), (unsigned)f2bf(v2) | ((unsigned)f2bf(v3) << 16)}; }
                asm volatile("" ::: "memory");
            }
        }
        (void)cur;
    }
}
__device__ __forceinline__ void sel_block_sw(LAS unsigned char* lds, int cb, int m, const unsigned long long (&mk4)[SEL_NQW], const bf16x8_t (&qf)[SEL_NPP][2], f32x4_t (&oacc)[SEL_NPP][4], float (&lsum)[SEL_NPP],
                                          float negB2, int q0, int w, int g, int hd, int kg, const LAS unsigned char* bkt, const LAS float* tabl) {
    constexpr int ROWB = 128, TILE_B = 64 * ROWB;
    const int swz = (kg ^ (hd & 7)) << 4;
#pragma unroll
    for (int pp = 0; pp < SEL_NPP; ++pp) {
        const bool selA = (mk4[2 * pp] >> m) & 1ull, selB = (mk4[2 * pp + 1] >> m) & 1ull;
        if (selA || selB) {
            const int qA = q0 + SEL_NQW * w + 2 * pp, q = qA + (hd >> 3);
            const bool mine = (hd & 8) ? selB : selA;
            f32x4_t st[4];
#pragma unroll
            for (int t16 = 0; t16 < 4; ++t16) {
                f32x4_t a = (f32x4_t){negB2, negB2, negB2, negB2};
#pragma unroll
                for (int ks = 0; ks < 2; ++ks) {
                    const bf16x8_t kf = *(const LAS bf16x8_t*)(lds + cb + (16 * t16 + hd) * ROWB + (swz ^ (64 * ks)));
                    a = __builtin_amdgcn_mfma_f32_16x16x32_bf16(kf, qf[pp][ks], a, 0, 0, 0);
                }
                st[t16] = a;
            }
            float ls = 0.f;
            const int dmin = qA - (64 * m + 63);
            if (dmin >= 0 && bkt[dmin] == 31) {
                const float bf_ = tabl[31 * 16 + g * 8 + (hd & 7)];
#pragma unroll
                for (int t16 = 0; t16 < 4; ++t16)
#pragma unroll
                    for (int rg = 0; rg < 4; ++rg) { float pe = __builtin_amdgcn_exp2f(st[t16][rg] + bf_); if (!mine) pe = 0.f; st[t16][rg] = pe; ls += pe; }
            } else {
#pragma unroll
                for (int t16 = 0; t16 < 4; ++t16)
#pragma unroll
                    for (int rg = 0; rg < 4; ++rg) {
                        const int d = q - (64 * m + 16 * t16 + 4 * kg + rg);
                        const float bb = tabl[(int)bkt[d & 4095] * 16 + g * 8 + (hd & 7)];
                        float pe = __builtin_amdgcn_exp2f(st[t16][rg] + bb);
                        if (d < 0 || !mine) pe = 0.f;
                        st[t16][rg] = pe; ls += pe;
                    }
            }
            lsum[pp] += ls;
#pragma unroll
            for (int kp = 0; kp < 2; ++kp) {
                u32x4_t pw; pw.x = cvtpk(st[2 * kp][0], st[2 * kp][1]); pw.y = cvtpk(st[2 * kp][2], st[2 * kp][3]);
                pw.z = cvtpk(st[2 * kp + 1][0], st[2 * kp + 1][1]); pw.w = cvtpk(st[2 * kp + 1][2], st[2 * kp + 1][3]);
                const bf16x8_t pf = __builtin_bit_cast(bf16x8_t, pw);
#pragma unroll
                for (int dt = 0; dt < 4; ++dt) {
                    const bf16x8_t vf = *(const LAS bf16x8_t*)(lds + cb + TILE_B + (16 * dt + hd) * ROWB + (swz ^ (64 * kp)));
                    oacc[pp][dt] = __builtin_amdgcn_mfma_f32_16x16x32_bf16(vf, pf, oacc[pp][dt], 0, 0, 0);
                }
            }
        }
    }
}


__device__ __forceinline__ unsigned ring_min8(const LAS unsigned* c8) {
    const u32x4_t a = *(const volatile LAS u32x4_t*)c8, b = *(const volatile LAS u32x4_t*)(c8 + 4);
    unsigned m0 = a.x < a.y ? a.x : a.y, m1 = a.z < a.w ? a.z : a.w, m2 = b.x < b.y ? b.x : b.y, m3 = b.z < b.w ? b.z : b.w;
    m0 = m0 < m1 ? m0 : m1; m2 = m2 < m3 ? m2 : m3; m0 = m0 < m2 ? m0 : m2;
    return (unsigned)__builtin_amdgcn_readfirstlane((int)m0);
}
__device__ __forceinline__ void ph_l1_sel_ring(const Params& p) {
    constexpr int R = 8, SLOT_B = 16384, O_BKT = R * SLOT_B, O_TABL = O_BKT + 4096, O_CNT = O_TABL + 2048;
    LAS unsigned char* lds = (LAS unsigned char*)g_lds;
    LAS unsigned char* bkt = lds + O_BKT; LAS float* tabl = (LAS float*)(lds + O_TABL);
    LAS unsigned* cnt = (LAS unsigned*)(lds + O_CNT);
    const bf16_t* Qn = (const bf16_t*)(p.ws + OFF_QN);
    const bf16_t* KV = (const bf16_t*)(p.ws + SM_KV);
    const bf16_t *KS = KV + 2 * (KVSZ / 2), *VS = KV + 3 * (KVSZ / 2);
    const float* gate = (const float*)(p.ws + SM_GATE); const float* tab = p.in[I_RELB];
    const unsigned long long* selm = (const unsigned long long*)(p.ws + SM_IDX);
    const bf16_t* acc_o = (const bf16_t*)(p.ws + OFF_BIG); bf16_t* nsa_o = (bf16_t*)(p.ws + OFF_BIG + (size_t)T_ * 4096);
    const int tid = TIDX, lane = tid & 63, w = __builtin_amdgcn_readfirstlane(tid >> 6), hd = lane & 15, kg = lane >> 4;
    const float negB2 = ((const float*)(p.ws + OFF_BOUND))[2];
    for (int i = tid; i < 1024; i += 512) ((LAS unsigned*)bkt)[i] = ((const unsigned*)(p.ws + OFF_BKT))[i];
    for (int i = tid; i < 512; i += 512) tabl[i] = tab[i] * LOG2E_;
    for (int uk = 0;; ++uk) {
        constexpr int NU = S_ / SEL_UQ;
        int bg, qt;
        if (gridDim.x == 256 && NU == 64 && B_ * 2 == 8) { if (uk >= 2) break; const int j = blockIdx.x >> 3; bg = blockIdx.x & 7; qt = uk ? NU - 1 - j : j; }
        else { const int unit = blockIdx.x + uk * gridDim.x; if (unit >= B_ * 2 * NU) break; bg = unit / NU; qt = unit % NU; }
        const int q0 = qt * SEL_UQ, b = bg >> 1, g = bg & 1;
        unsigned long long U = 0ull;
        for (int j = 0; j < SEL_UQ; ++j) U |= __hip_atomic_load(selm + (size_t)bg * S_ + q0 + j, __ATOMIC_RELAXED, __HIP_MEMORY_SCOPE_AGENT);
        unsigned long long mk4[SEL_NQW];
#pragma unroll
        for (int j = 0; j < SEL_NQW; ++j) { const unsigned long long v = __hip_atomic_load(selm + (size_t)bg * S_ + q0 + SEL_NQW * w + j, __ATOMIC_RELAXED, __HIP_MEMORY_SCOPE_AGENT);
            mk4[j] = ((unsigned long long)(unsigned)__builtin_amdgcn_readfirstlane((unsigned)(v >> 32)) << 32) | (unsigned long long)(unsigned)__builtin_amdgcn_readfirstlane((unsigned)v); }
        U = ((unsigned long long)(unsigned)__builtin_amdgcn_readfirstlane((unsigned)(U >> 32)) << 32) | (unsigned long long)(unsigned)__builtin_amdgcn_readfirstlane((unsigned)U);
        unsigned long long mkw = 0ull;
#pragma unroll
        for (int j = 0; j < SEL_NQW; ++j) mkw |= mk4[j];
        bf16x8_t qf[SEL_NPP][2];
#pragma unroll
        for (int pp = 0; pp < SEL_NPP; ++pp)
#pragma unroll
            for (int ks = 0; ks < 2; ++ks)
                qf[pp][ks] = *(const bf16x8_t*)(Qn + ((size_t)(b * 16 + g * 8 + (hd & 7)) * S_ + q0 + SEL_NQW * w + 2 * pp + (hd >> 3)) * 64 + 32 * ks + 8 * kg);
        f32x4_t oacc[SEL_NPP][4]; float lsum[SEL_NPP];
#pragma unroll
        for (int pp = 0; pp < SEL_NPP; ++pp) { lsum[pp] = 0.f;
#pragma unroll
            for (int dt = 0; dt < 4; ++dt) oacc[pp][dt] = (f32x4_t){0.f, 0.f, 0.f, 0.f}; }
        const bf16_t* Kg = KS + (size_t)bg * S_ * 64;
        const bf16_t* Vg = VS + (size_t)bg * 64 * S_;
        const int lrow = 8 * w + (lane >> 3), lch = (lane & 7) ^ (lane >> 3);
        const bf16_t* kl = Kg + (size_t)lrow * 64 + lch * 8;
        const bf16_t* vl = Vg + (size_t)lrow * S_ + lch * 8;
#pragma unroll
        for (int pp = 0; pp < SEL_NPP; ++pp) asm volatile("" : "+v"(qf[pp][0]), "+v"(qf[pp][1]));
        asm volatile("s_waitcnt vmcnt(0)" ::: "memory");
        __syncthreads();
        if (lane == 0) { cnt[w] = 0u; cnt[8 + w] = 0u; }
        __syncthreads();
        const int NB = __builtin_popcountll(U);
        int n_load = 0, n_pub = 0;
        unsigned long long remL = U, remC = U;
#define RING_ISSUE() do { const unsigned mp_ = ring_min8(cnt); \
            while (n_load < NB && n_load < (int)mp_ + R) { const int ml_ = __builtin_ctzll(remL); remL &= remL - 1; const int so_ = (n_load & (R - 1)) * SLOT_B + w * 1024; \
                __builtin_amdgcn_global_load_lds((const unsigned*)(kl + (size_t)ml_ * 4096), (LAS unsigned*)(lds + so_), 16, 0, 0); \
                __builtin_amdgcn_global_load_lds((const unsigned*)(vl + (size_t)ml_ * 64), (LAS unsigned*)(lds + so_ + 8192), 16, 0, 0); ++n_load; } } while (0)
#define RING_PUBLISH() do { asm volatile("s_waitcnt vmcnt(0)" ::: "memory"); if (lane == 0) *(volatile LAS unsigned*)(cnt + 8 + w) = (unsigned)n_load; n_pub = n_load; } while (0)
        int fmin = 0;
        for (int n = 0; n < NB; ++n) {
            const int m = __builtin_ctzll(remC); remC &= remC - 1;
            if (n_pub < n_load) RING_PUBLISH();
            if (n_load < NB) RING_ISSUE();
            if ((mkw >> m) & 1ull) {
                while (fmin <= n) {
                    fmin = (int)ring_min8(cnt + 8);
                    if (fmin > n) break;
                    if (n_pub < n_load) RING_PUBLISH(); else __builtin_amdgcn_s_sleep(1);
                    if (n_load < NB) RING_ISSUE();
                }
                asm volatile("" ::: "memory");
                sel_block_sw(lds, (n & (R - 1)) * SLOT_B, m, mk4, qf, oacc, lsum, negB2, q0, w, g, hd, kg, bkt, tabl);
                asm volatile("s_waitcnt lgkmcnt(0)" ::: "memory");
            }
            if (lane == 0) *(volatile LAS unsigned*)(cnt + w) = (unsigned)(n + 1);
        }
        while (n_load < NB || n_pub < n_load) {
            if (n_pub < n_load) RING_PUBLISH(); else __builtin_amdgcn_s_sleep(1);
            if (n_load < NB) RING_ISSUE();
        }
#undef RING_ISSUE
#undef RING_PUBLISH
        {
            typedef unsigned u32x2s __attribute__((ext_vector_type(2)));
#pragma unroll
            for (int pp = 0; pp < SEL_NPP; ++pp) { float l = lsum[pp]; l += __shfl_xor(l, 16); l += __shfl_xor(l, 32);
                const size_t t = (size_t)b * S_ + q0 + SEL_NQW * w + 2 * pp + (hd >> 3); const int h = g * 8 + (hd & 7);
                const float sc = gate[t * 48 + h * 3 + 1] / l;
                u32x2s prev[4];
#pragma unroll
                for (int dt = 0; dt < 4; ++dt) { const unsigned long long pv_ = __hip_atomic_load((const unsigned long long*)(acc_o + t * 1024 + h * 64 + 16 * dt + 4 * kg), __ATOMIC_RELAXED, __HIP_MEMORY_SCOPE_AGENT); prev[dt] = (u32x2s){(unsigned)pv_, (unsigned)(pv_ >> 32)}; }
#pragma unroll
                for (int dt = 0; dt < 4; ++dt) { const f32x4_t a = oacc[pp][dt] * sc;
                    const float v0 = u2f(prev[dt].x << 16) + a[0], v1 = u2f(prev[dt].x & 0xffff0000u) + a[1], v2 = u2f(prev[dt].y << 16) + a[2], v3 = u2f(prev[dt].y & 0xffff0000u) + a[3];
                    *(u32x2s*)(nsa_o + t * 1024 + h * 64 + 16 * dt + 4 * kg) = (u32x2s){(unsigned)f2bf(v0) | ((unsigned)f2bf(v1) << 16), (unsigned)f2bf(v2) | ((unsigned)f2bf(v3) << 16)}; }
                asm volatile("" ::: "memory");
            }
        }
    }
}
#endif

#ifndef CPU_EMU
__device__ __forceinline__ void win_tile(LAS unsigned char* lds, int cur, int kt, const bf16x8_t (&qf)[4], f32x16& o0, f32x16& o1, float& l, float negB2, int qg, int r, int hh, const LAS float* mylut) {
    constexpr int ROWB = 144, TILE_B = 64 * ROWB;
            {
    f32x16 s0, s1;
#pragma unroll
    for (int i = 0; i < 16; ++i) { s0[i] = negB2; s1[i] = negB2; }
#pragma unroll
    for (int ks = 0; ks < 4; ++ks) {
        const bf16x8_t k0 = *(const LAS bf16x8_t*)(lds + cur + r * ROWB + (16 * ks + 8 * hh) * 2);
        const bf16x8_t k1 = *(const LAS bf16x8_t*)(lds + cur + (32 + r) * ROWB + (16 * ks + 8 * hh) * 2);
        s0 = __builtin_amdgcn_mfma_f32_32x32x16_bf16(k0, qf[ks], s0, 0, 0, 0);
        s1 = __builtin_amdgcn_mfma_f32_32x32x16_bf16(k1, qf[ks], s1, 0, 0, 0);
    }
    float ls = 0.f;
    int hq = hh, qq = qg; asm volatile("" : "+v"(hq), "+v"(qq));
    const int q0w = qg - r;
    if (q0w - (64 * kt + 63) >= 0 && q0w + 31 - 64 * kt <= 511) {
#pragma unroll
        for (int i = 0; i < 16; ++i) {
            const int d0 = qq - (64 * kt + crow(i, hq));
            const float p0 = __builtin_amdgcn_exp2f(s0[i] + mylut[d0]), p1 = __builtin_amdgcn_exp2f(s1[i] + mylut[d0 - 32]);
            s0[i] = p0; s1[i] = p1; ls += p0 + p1;
        }
    } else {
#pragma unroll
    for (int i = 0; i < 16; ++i) {
        const int d0 = qq - (64 * kt + crow(i, hq)), d1 = d0 - 32;
        const float b0 = mylut[d0 & 511], b1 = mylut[d1 & 511];
        float p0 = __builtin_amdgcn_exp2f(s0[i] + b0), p1 = __builtin_amdgcn_exp2f(s1[i] + b1);
        if ((unsigned)d0 > 511u) p0 = 0.f;
        if ((unsigned)d1 > 511u) p1 = 0.f;
        s0[i] = p0; s1[i] = p1; ls += p0 + p1;
    }
    }
    l += ls;
    const bf16x8_t pa = pack8(s0, 0), pb = pack8(s0, 8), pc = pack8(s1, 0), pd = pack8(s1, 8);
    const LAS unsigned char* vb = lds + cur + TILE_B + r * ROWB + 8 * hh * 2;
#define PV_STEP(PF, SP) do { const bf16x8_t v0 = *(const LAS bf16x8_t*)(vb + (SP) * 32); const bf16x8_t v1 = *(const LAS bf16x8_t*)(vb + 32 * ROWB + (SP) * 32); \
        o0 = __builtin_amdgcn_mfma_f32_32x32x16_bf16(PF, v0, o0, 0, 0, 0); o1 = __builtin_amdgcn_mfma_f32_32x32x16_bf16(PF, v1, o1, 0, 0, 0); } while (0)
    PV_STEP(pa, 0); PV_STEP(pb, 1); PV_STEP(pc, 2); PV_STEP(pd, 3);
#undef PV_STEP
}
}

__device__ __forceinline__ void ph_l1_win_mfma(const Params& p) {
    constexpr int ROWB = 144, TILE_B = 64 * ROWB, BUF_B = 2 * TILE_B;
    LAS unsigned char* lds = (LAS unsigned char*)g_lds;
    LAS float* lut = (LAS float*)(lds + 2 * BUF_B);
    LAS float* lsum = (LAS float*)(lds + 2 * BUF_B + 16 * 512 * 4);
    const bf16_t* Qn = (const bf16_t*)(p.ws + OFF_QN);
    const bf16_t* KV = (const bf16_t*)(p.ws + SM_KV);
    const bf16_t *KW = KV + 4 * (KVSZ / 2), *VW = KV + 5 * (KVSZ / 2);
    const float* gate = (const float*)(p.ws + SM_GATE); const float* tab = p.in[I_RELB];
    bf16_t* acc_o = (bf16_t*)(p.ws + OFF_BIG);
    const int tid = TIDX, lane = tid & 63, w = __builtin_amdgcn_readfirstlane(tid >> 6), r = lane & 31, hh = lane >> 5;
    const float negB2 = ((const float*)(p.ws + OFF_BOUND))[3];
    {
        const int bk = (int)((const unsigned char*)(p.ws + OFF_BKT))[tid & 511];
        f32x4 tb[4];
#pragma unroll
        for (int q = 0; q < 4; ++q) tb[q] = *(const f32x4*)(tab + bk * 16 + 4 * q);
#pragma unroll
        for (int q = 0; q < 4; ++q)
#pragma unroll
            for (int j = 0; j < 4; ++j) lut[(4 * q + j) * 512 + (tid & 511)] = tb[q][j] * LOG2E_;
    }
    __syncthreads();
    for (int uk = 0;; ++uk) {
        int bg, qt; if (!nsa_unit(uk, bg, qt)) break;
        const int q0 = qt * 32, b = bg >> 1, g = bg & 1, h = g * 8 + w;
        const int qg = q0 + r;
        const int kt_lo = (q0 - 511 > 0 ? q0 - 511 : 0) >> 6, kt_hi = (q0 + 31) >> 6;
        const bf16_t* Kg = KW + (size_t)bg * S_ * 64;
        const bf16_t* Vg = VW + (size_t)bg * 64 * S_;
        bf16x8_t qf[4];
        { const bf16_t* Qp = Qn + ((size_t)(b * 16 + h) * S_ + qg) * 64;
#pragma unroll
          for (int ks = 0; ks < 4; ++ks) qf[ks] = *(const bf16x8_t*)(Qp + 16 * ks + 8 * hh); }
        f32x16 o0, o1;
#pragma unroll
        for (int i = 0; i < 16; ++i) { o0[i] = 0.f; o1[i] = 0.f; }
        float l = 0.f;
        const int srow = tid >> 3, sch = tid & 7, kdst = srow * ROWB + sch * 16, vdst = TILE_B + kdst;
        u32x4_t ak, av, bk, bv, ck, cv_;
        const LAS float* mylut = lut + h * 512;
        const int NT = kt_hi - kt_lo + 1;
#define WIN_LOAD(T, RK, RV) do { GLD16(RK, Kg + (size_t)((kt_lo + (T)) * 64 + srow) * 64 + sch * 8); GLD16(RV, Vg + (size_t)srow * S_ + (kt_lo + (T)) * 64 + sch * 8); } while (0)
#define WIN_WAIT(N, RK, RV) asm volatile("s_waitcnt vmcnt(" #N ")" : "+v"(RK), "+v"(RV) :: "memory")
#define WIN_STEP(WK, WV, IK, IV) { if (t + 3 < NT) WIN_LOAD(t + 3, IK, IV); \
            win_tile(lds, cur, kt_lo + t, qf, o0, o1, l, negB2, qg, r, hh, mylut); \
            if (t + 1 < NT) { if (t + 3 < NT) WIN_WAIT(4, WK, WV); else if (t + 2 < NT) WIN_WAIT(2, WK, WV); else WIN_WAIT(0, WK, WV); *(LAS u32x4_t*)(lds + nxt + kdst) = WK; *(LAS u32x4_t*)(lds + nxt + vdst) = WV; } \
            __syncthreads(); if (++t >= NT) break; cur = nxt; nxt = BUF_B - cur; }
        asm volatile("" : "+v"(qf[0]), "+v"(qf[1]), "+v"(qf[2]), "+v"(qf[3]));
        asm volatile("s_waitcnt vmcnt(0)" ::: "memory");
        WIN_LOAD(0, ak, av); WIN_WAIT(0, ak, av);
        *(LAS u32x4_t*)(lds + kdst) = ak; *(LAS u32x4_t*)(lds + vdst) = av;
        if (NT > 1) WIN_LOAD(1, ak, av);
        if (NT > 2) WIN_LOAD(2, bk, bv);
        __syncthreads();
        int t = 0, cur = 0, nxt = BUF_B;
        for (;;) {
            WIN_STEP(ak, av, ck, cv_)
            WIN_STEP(bk, bv, ak, av)
            WIN_STEP(ck, cv_, bk, bv)
        }
#undef WIN_STEP
#undef WIN_LOAD
#undef WIN_WAIT
        l += __shfl_xor(l, 32);
        if (hh == 0) lsum[w * 32 + r] = l;
        __builtin_amdgcn_s_waitcnt(0xc07f);
        __builtin_amdgcn_wave_barrier();
        {
            float gsc[16];
#pragma unroll
            for (int i = 0; i < 16; ++i) { const int qr = crow(i, hh); gsc[i] = gate[((size_t)b * S_ + q0 + qr) * 48 + h * 3 + 2] / lsum[w * 32 + qr]; }
#pragma unroll
            for (int i = 0; i < 16; ++i) { const size_t o = ((size_t)b * S_ + q0 + crow(i, hh)) * 1024 + h * 64 + r; acc_o[o] = f2bf(o0[i] * gsc[i]); acc_o[o + 32] = f2bf(o1[i] * gsc[i]); }
        }
    }
}
#endif

struct EStoreF32 { float* out; int ldc; int ncols;
    MEMFN void operator()(int row, int col, f32x4 v) const { if (col < ncols) *(f32x4*)(out + (size_t)row * ldc + col) = v; } };
struct EResAddF32 { const float* res; float* out; int ldc;
    MEMFN void operator()(int row, int col, f32x4 v) const { const f32x4 r = *(const f32x4*)(res + (size_t)row * ldc + col); *(f32x4*)(out + (size_t)row * ldc + col) = r + v; } };
struct EStoreBf16 { bf16_t* out; int ldc;
    MEMFN void operator()(int row, int col, f32x4 v) const { typedef unsigned u32x2s_ __attribute__((ext_vector_type(2)));
        *(u32x2s_*)(out + (size_t)row * ldc + col) = (u32x2s_){(unsigned)f2bf(v[0]) | ((unsigned)f2bf(v[1]) << 16), (unsigned)f2bf(v[2]) | ((unsigned)f2bf(v[3]) << 16)}; } };
struct ERelu2Bf16 { bf16_t* out; int ldc;
    MEMFN void operator()(int row, int col, f32x4 v) const { bf16_t* d = out + (size_t)row * ldc + col;
        for (int j = 0; j < 4; ++j) { const float r = v[j] > 0.f ? v[j] : 0.f; d[j] = f2bf(r * r); } } };
struct EGeluBiasBf16 { bf16_t* out; int ldc; const float* bias;
    MEMFN void operator()(int row, int col, f32x4 v) const { bf16_t* d = out + (size_t)row * ldc + col;
        for (int j = 0; j < 4; ++j) d[j] = f2bf(gelu_tanh(v[j] + bias[col + j])); } };

#ifdef CPU_EMU
template <class F> static void gemm_emu(const bf16_t* A, int lda, const bf16_t* Bt, int M, int N, int K, const F& f) {
    if (GTID != 0) return;
#pragma omp parallel for
    for (int r = 0; r < M; ++r) {
        static thread_local float* arow = nullptr; if (!arow) arow = new float[8192];
        for (int k = 0; k < K; ++k) arow[k] = bf2f(A[(size_t)r * lda + k]);
        for (int c = 0; c < N; c += 4) { f32x4 acc = {0.f, 0.f, 0.f, 0.f};
            for (int j = 0; j < 4; ++j) { const bf16_t* brow = Bt + (size_t)(c + j) * K; float s = 0.f; for (int k = 0; k < K; ++k) s += arow[k] * bf2f(brow[k]); acc[j] = s; }
            f(r, c, acc); }
    }
}
#define GEMM(A, lda, Bt, M, N, K, f) gemm_emu(A, lda, Bt, M, N, K, f)
#else
namespace pg8 {
#define PG8_LAS __attribute__((address_space(3)))
typedef short bf16x8 __attribute__((ext_vector_type(8)));
constexpr int BM = 256, BK = 64, HALF = 128, HTB = HALF * BK * 2, STAGE_BYTES = 8 * HTB, NXCD = 8, WGM = 8;
__host__ __device__ __forceinline__ int lds_byte(int r, int c) { const int st = (r >> 4) * 2 + (c >> 5), rr = r & 15, cc = c & 31, ob = rr * 64 + cc * 2; return st * 1024 + (ob ^ (((ob >> 9) & 1) << 5)); }
__host__ __device__ __forceinline__ void stage_rc(int b, int& R, int& C) { const int st = b / 1024, sb = b % 1024, swz = sb ^ (((sb >> 9) & 1) << 5); R = (st >> 1) * 16 + swz / 64; C = (st & 1) * 32 + (swz % 64) / 2; }
struct Unit { int pm, pn; };
struct Gemm { const bf16_t* A; const bf16_t* Bt; int M, N, K, lda, ldb; };
struct StaticOrder {
    int nM, nN, nwg, G, c;
    __host__ __device__ void init(int M, int N, int G_, int c_) { nM = M / BM; nN = N / BM; nwg = nM * nN; G = G_; c = c_; }
    __host__ __device__ bool next(int i, Unit& u) const {
        const long L = (long)i * G + c; if (L >= nwg) return false;
        int wgid = (int)L; { const int q = nwg / NXCD, r = nwg % NXCD, xcd = wgid % NXCD, off = wgid / NXCD; wgid = (xcd < r ? xcd * (q + 1) : r * (q + 1) + (xcd - r) * q) + off; }
        const int nig = WGM * nN, gid = wgid / nig, fm = gid * WGM, gsz = (nM - fm) < WGM ? (nM - fm) : WGM;
        u.pm = fm + ((wgid % nig) % gsz); u.pn = (wgid % nig) / gsz; return true;
    }
};
template <class F> struct EpiElem {
    F f;
    __device__ __forceinline__ void operator()(const f32x4 (&acc)[2][2][4][2], const Unit& u, int wr, int wc, int fr, int fq) const {
        asm volatile("" : "+v"(fr), "+v"(fq));
#pragma unroll
        for (int ai = 0; ai < 2; ++ai)
#pragma unroll
            for (int m = 0; m < 4; ++m) { const int row = u.pm * BM + ai * HALF + wr * 64 + m * 16 + fr;
#pragma unroll
                for (int bj = 0; bj < 2; ++bj)
#pragma unroll
                    for (int n = 0; n < 2; ++n) f(row, u.pn * BM + bj * HALF + wc * 32 + n * 16 + 4 * fq, acc[ai][bj][m][n]); }
    }
};

__device__ __forceinline__ void row_rstd8(const float* ssq, int row0, int fq, float (&rstd)[2][4]) {
    f32x4 part[2][4];
#pragma unroll
    for (int ai = 0; ai < 2; ++ai)
#pragma unroll
        for (int m = 0; m < 4; ++m) part[ai][m] = *(const f32x4*)(ssq + (size_t)(row0 + ai * HALF + m * 16) * 16 + 4 * fq);
#pragma unroll
    for (int ai = 0; ai < 2; ++ai)
#pragma unroll
        for (int m = 0; m < 4; ++m) { const f32x4 a = part[ai][m]; float t = (a[0] + a[1]) + (a[2] + a[3]); t += __shfl_xor(t, 16); t += __shfl_xor(t, 32);
            rstd[ai][m] = 1.0f / sqrtf(t * (1.0f / 1024.0f) + EPS_); }
}
template <class F> struct EpiRowScale {
    F f; const float* ssq;
    __device__ __forceinline__ void operator()(const f32x4 (&acc)[2][2][4][2], const Unit& u, int wr, int wc, int fr, int fq) const {
        asm volatile("" : "+v"(fr), "+v"(fq));
        float rs8[2][4]; row_rstd8(ssq, u.pm * BM + wr * 64 + fr, fq, rs8);
#pragma unroll
        for (int ai = 0; ai < 2; ++ai)
#pragma unroll
            for (int m = 0; m < 4; ++m) { const int row = u.pm * BM + ai * HALF + wr * 64 + m * 16 + fr;
                const float rstd = rs8[ai][m];
#pragma unroll
                for (int bj = 0; bj < 2; ++bj)
#pragma unroll
                    for (int n = 0; n < 2; ++n) f(row, u.pn * BM + bj * HALF + wc * 32 + n * 16 + 4 * fq, acc[ai][bj][m][n] * rstd); }
    }
};
template <bool RES_F32, bool OUT_F32> struct EpiResNorm {
    const float* resf; const bf16_t* resb; float* outf; bf16_t* xb; float* ssq;
    static constexpr int GM = RES_F32 ? 2 : 4, NG = 8 / GM;
    struct Piece { f32x4 f0, f1; u32x4e b; };
    __device__ __forceinline__ void load_group(int gi, Piece (&P)[GM][2], const Unit& u, int wr, int wc, int fr, int fq) const {
#pragma unroll
        for (int mi = 0; mi < GM; ++mi) { const int am = gi * GM + mi, ai = am >> 2, m = am & 3; const int row = u.pm * BM + ai * HALF + wr * 64 + m * 16 + fr;
#pragma unroll
            for (int bj = 0; bj < 2; ++bj) { const size_t o = (size_t)row * 1024 + u.pn * BM + bj * HALF + wc * 32 + 8 * fq;
                if (RES_F32) { P[mi][bj].f0 = *(const f32x4*)(resf + o); P[mi][bj].f1 = *(const f32x4*)(resf + o + 4); } else P[mi][bj].b = *(const u32x4e*)(resb + o); } }
    }
    __device__ __forceinline__ void operator()(const f32x4 (&acc)[2][2][4][2], const Unit& u, int wr, int wc, int fr, int fq) const {
        asm volatile("" : "+v"(fr), "+v"(fq));
        Piece cur[GM][2], nxt[GM][2];
        load_group(0, cur, u, wr, wc, fr, fq);
#pragma unroll
        for (int gi = 0; gi < NG; ++gi) {
            if (gi + 1 < NG) load_group(gi + 1, nxt, u, wr, wc, fr, fq);
#pragma unroll
            for (int mi = 0; mi < GM; ++mi) { const int am = gi * GM + mi, ai = am >> 2, m = am & 3; const int row = u.pm * BM + ai * HALF + wr * 64 + m * 16 + fr; float ss = 0.f;
#pragma unroll
                for (int bj = 0; bj < 2; ++bj) { const size_t o = (size_t)row * 1024 + u.pn * BM + bj * HALF + wc * 32 + 8 * fq;
                    f32x4 r0, r1;
                    if (RES_F32) { r0 = cur[mi][bj].f0; r1 = cur[mi][bj].f1; }
                    else { const u32x4e rb = cur[mi][bj].b; r0 = (f32x4){u2f(rb.x << 16), u2f(rb.x & 0xffff0000u), u2f(rb.y << 16), u2f(rb.y & 0xffff0000u)};
                                                           r1 = (f32x4){u2f(rb.z << 16), u2f(rb.z & 0xffff0000u), u2f(rb.w << 16), u2f(rb.w & 0xffff0000u)}; }
                    const f32x4 v0 = r0 + acc[ai][bj][m][0], v1 = r1 + acc[ai][bj][m][1];
                    if (OUT_F32) { *(f32x4*)(outf + o) = v0; *(f32x4*)(outf + o + 4) = v1; }
                    else { const unsigned w0 = (unsigned)f2bf(v0[0]) | ((unsigned)f2bf(v0[1]) << 16), w1 = (unsigned)f2bf(v0[2]) | ((unsigned)f2bf(v0[3]) << 16),
                                          w2 = (unsigned)f2bf(v1[0]) | ((unsigned)f2bf(v1[1]) << 16), w3 = (unsigned)f2bf(v1[2]) | ((unsigned)f2bf(v1[3]) << 16);
                        *(u32x4e*)(xb + o) = (u32x4e){w0, w1, w2, w3};
                        const float q0 = u2f(w0 << 16), q1 = u2f(w0 & 0xffff0000u), q2 = u2f(w1 << 16), q3 = u2f(w1 & 0xffff0000u), q4 = u2f(w2 << 16), q5 = u2f(w2 & 0xffff0000u), q6 = u2f(w3 << 16), q7 = u2f(w3 & 0xffff0000u);
                        ss += ((q0 * q0 + q1 * q1) + (q2 * q2 + q3 * q3)) + ((q4 * q4 + q5 * q5) + (q6 * q6 + q7 * q7)); } }
                if (!OUT_F32) { ss += __shfl_xor(ss, 16); ss += __shfl_xor(ss, 32);
                    if (fq == 0) ssq[(size_t)row * 16 + u.pn * 4 + wc] = ss; } }
            asm volatile("" ::: "memory");
#pragma unroll
            for (int mi = 0; mi < GM; ++mi)
#pragma unroll
                for (int bj = 0; bj < 2; ++bj) cur[mi][bj] = nxt[mi][bj];
        }
    }
};
template <bool QPART> struct EpiNsaIn {
    const float* ssq; const float* gq; const float* gk; bf16_t* Qn; bf16_t* KV; float* gate;
    __device__ __forceinline__ void operator()(const f32x4 (&acc)[2][2][4][2], const Unit& u, int wr, int wc, int fr, int fq) const {
        asm volatile("" : "+v"(fr), "+v"(fq));
        const int unit = u.pn * 4 + wc + (QPART ? 0 : 16);
        if (unit > 28) return;
        const bool is_q = QPART; const int x = (unit - 16) >> 1, gg = (unit - 16) & 1;
        const bool normed = is_q || x == 2 || x == 4;
        const float* g = is_q ? gq : (x == 2 ? gk + 64 : gk + 128);
        const float qs = is_q ? 0.125f * LOG2E_ : 1.0f;
        float rs8[2][4]; row_rstd8(ssq, u.pm * BM + wr * 64 + fr, fq, rs8);
        f32x4 gv[2][2];
#pragma unroll
        for (int bj = 0; bj < 2; ++bj)
#pragma unroll
            for (int n = 0; n < 2; ++n) gv[bj][n] = normed ? *(const f32x4*)(g + 32 * bj + 16 * n + 4 * fq) : (f32x4){1.f, 1.f, 1.f, 1.f};
#pragma unroll
        for (int ai = 0; ai < 2; ++ai)
#pragma unroll
            for (int m = 0; m < 4; ++m) { const int t = u.pm * BM + ai * HALF + wr * 64 + m * 16 + fr; const int b = t / S_, s = t - b * S_;
                const float rstd = rs8[ai][m];
                float ss = 0.f;
#pragma unroll
                for (int bj = 0; bj < 2; ++bj)
#pragma unroll
                    for (int n = 0; n < 2; ++n) { const f32x4 w = acc[ai][bj][m][n]; ss += (w[0] * w[0] + w[1] * w[1]) + (w[2] * w[2] + w[3] * w[3]); }
                float fsc = rstd;
                if (normed) { ss += __shfl_xor(ss, 16); ss += __shfl_xor(ss, 32); fsc = rstd * qs / sqrtf(ss * rstd * rstd * (1.0f / 64.0f) + EPS_); }
#define NSA_V(bj, n) (normed ? acc[ai][bj][m][n] * gv[bj][n] * fsc : acc[ai][bj][m][n] * fsc)
                if (unit == 28) {
#pragma unroll
                    for (int bj = 0; bj < 2; ++bj)
#pragma unroll
                        for (int n = 0; n < 2; ++n)
#pragma unroll
                            for (int j = 0; j < 4; ++j) { const int c = 32 * bj + 16 * n + 4 * fq + j; if (c < 48) gate[(size_t)t * 48 + c] = 1.0f / (1.0f + expf(-(NSA_V(bj, n))[j])); }
                } else if (!is_q && (x == 3 || x == 5)) {
                    PG8_LAS unsigned char* scr = (PG8_LAS unsigned char*)g_lds + 131072 + (wr * 4 + wc) * 2048;
#pragma unroll
                    for (int bj = 0; bj < 2; ++bj)
#pragma unroll
                        for (int n = 0; n < 2; ++n)
#pragma unroll
                            for (int j = 0; j < 4; ++j) *(PG8_LAS bf16_t*)(scr + (32 * bj + 16 * n + 4 * fq + j) * 32 + fr * 2) = f2bf((NSA_V(bj, n))[j]);
                    asm volatile("s_waitcnt lgkmcnt(0)" ::: "memory");
                    const int t0 = t - fr, s0 = t0 - b * S_; const int lane_ = fq * 16 + fr;
#pragma unroll
                    for (int k = 0; k < 4; ++k) { const int piece = lane_ + 64 * k, d = piece >> 2, run = piece & 3;
                        typedef unsigned u32x2_ __attribute__((ext_vector_type(2)));
                        const u32x2_ vv = *(const PG8_LAS u32x2_*)(scr + d * 32 + run * 8);
                        const int pos = (x == 3) ? ((s0 & ~31) | (8 * run + 4 * ((s0 >> 4) & 1))) : ((s0 & ~15) | (8 * (run & 1) + 4 * (run >> 1)));
                        *(u32x2_*)(KV + (size_t)x * (KVSZ / 2) + ((size_t)(b * 2 + gg) * 64 + d) * S_ + pos) = vv; }
                    asm volatile("s_waitcnt lgkmcnt(0)" ::: "memory");
                } else {
                    bf16_t* base = is_q ? Qn + ((size_t)(b * 16 + unit) * S_ + s) * 64 : KV + (size_t)x * (KVSZ / 2) + ((size_t)(b * 2 + gg) * S_ + s) * 64;
                    typedef unsigned u32x2_ __attribute__((ext_vector_type(2)));
#pragma unroll
                    for (int bj = 0; bj < 2; ++bj)
#pragma unroll
                        for (int n = 0; n < 2; ++n) { const f32x4 w = NSA_V(bj, n);
                            *(u32x2_*)(base + 32 * bj + 16 * n + 4 * fq) = (u32x2_){(unsigned)f2bf(w[0]) | ((unsigned)f2bf(w[1]) << 16), (unsigned)f2bf(w[2]) | ((unsigned)f2bf(w[3]) << 16)}; }
                }
                asm volatile("" ::: "memory");
            }
#undef NSA_V
    }
};

struct EpiGates {
    const bf16_t* xc; float* z0; const float *ba, *bx, *lam; int col0;
    __device__ __forceinline__ void operator()(const f32x4 (&acc)[2][2][4][2], const Unit& u, int wr, int wc, int fr, int fq) const {
        asm volatile("" : "+v"(fr), "+v"(fq));
        float sp[2][2][2], b_a[2][2][2], b_x[2][2][2];
#pragma unroll
        for (int bj = 0; bj < 2; ++bj)
#pragma unroll
            for (int n = 0; n < 2; ++n)
#pragma unroll
                for (int j = 0; j < 2; ++j) { const int c = (col0 + u.pn * BM + bj * HALF + wc * 32 + n * 16 + 4 * fq) / 2 + j;
                    sp[bj][n][j] = log1pf(expf(-lam[c])); b_a[bj][n][j] = ba[c]; b_x[bj][n][j] = bx[c]; }
#pragma unroll
        for (int ai = 0; ai < 2; ++ai) {
            unsigned xw8[4][2][2];
#pragma unroll
            for (int m = 0; m < 4; ++m)
#pragma unroll
                for (int bj = 0; bj < 2; ++bj)
#pragma unroll
                    for (int n = 0; n < 2; ++n) xw8[m][bj][n] = *(const unsigned*)(xc + (size_t)(u.pm * BM + ai * HALF + wr * 64 + m * 16 + fr) * 512 + (col0 + u.pn * BM + bj * HALF + wc * 32 + n * 16 + 4 * fq) / 2);
#pragma unroll
            for (int m = 0; m < 4; ++m) { const int t = u.pm * BM + ai * HALF + wr * 64 + m * 16 + fr; const bool first = (t % S_) == 0;
#pragma unroll
                for (int bj = 0; bj < 2; ++bj)
#pragma unroll
                    for (int n = 0; n < 2; ++n) { const int c0 = (col0 + u.pn * BM + bj * HALF + wc * 32 + n * 16 + 4 * fq) / 2;
                        const unsigned xw = xw8[m][bj][n]; const f32x4 v = acc[ai][bj][m][n];
                        float av[2], bv[2];
#pragma unroll
                        for (int j = 0; j < 2; ++j) { const float xv = u2f(j ? (xw & 0xffff0000u) : (xw << 16));
                            const float r = 1.0f / (1.0f + expf(-(v[2 * j] + b_a[bj][n][j]))), ig = 1.0f / (1.0f + expf(-(v[2 * j + 1] + b_x[bj][n][j])));
                            const float log_a = -8.0f * r * sp[bj][n][j];
                            av[j] = expf(log_a); const float mult = first ? 1.0f : sqrtf(-expm1f(2.0f * log_a)); bv[j] = mult * (ig * xv); }
                        typedef float f32x2_ __attribute__((ext_vector_type(2)));
                        *(f32x2_*)(z0 + (size_t)t * 1024 + c0) = (f32x2_){av[0], av[1]}; *(f32x2_*)(z0 + (size_t)t * 1024 + 512 + c0) = (f32x2_){bv[0], bv[1]}; }
                asm volatile("" ::: "memory");
            }
        }
    }
};

struct EpiMlaKV {
    unsigned char* ws; unsigned char* outb; const float* gk;
    __device__ __forceinline__ void operator()(const f32x4 (&acc)[2][2][4][2], const Unit& u, int wr, int wc, int fr, int fq) const {
        asm volatile("" : "+v"(fr), "+v"(fq));
        const float* kr = (const float*)(ws + SM_KROPE); const float* rope = (const float*)(ws + OFF_ROPE); bf16_t* K0 = (bf16_t*)(outb + DO_K0); bf16_t* V0 = (bf16_t*)(outb + DO_V0);
        const int unit = u.pn * 4 + wc, h = unit >> 1; const bool isv = unit & 1;
        typedef unsigned u32x2_ __attribute__((ext_vector_type(2)));
        if (isv) {
            const int wid8 = wr * 4 + wc; const int lane = fq * 16 + fr;
            PG8_LAS unsigned char* scr = (PG8_LAS unsigned char*)g_lds + 131072 + wid8 * 2048;
            const int pfr = 8 * ((fr >> 2) & 1) + 4 * ((fr >> 3) & 1) + (fr & 3);
#pragma unroll
            for (int ai = 0; ai < 2; ++ai)
#pragma unroll
                for (int m = 0; m < 4; ++m) { const int t0 = u.pm * BM + ai * HALF + wr * 64 + m * 16; const int b = t0 / S_, s0 = t0 - b * S_;
#pragma unroll
                    for (int bj = 0; bj < 2; ++bj)
#pragma unroll
                        for (int n = 0; n < 2; ++n)
#pragma unroll
                            for (int j = 0; j < 4; ++j) *(PG8_LAS bf16_t*)(scr + (32 * bj + 16 * n + 4 * fq + j) * 32 + pfr * 2) = f2bf(acc[ai][bj][m][n][j]);
                    asm volatile("s_waitcnt lgkmcnt(0)" ::: "memory");
#pragma unroll
                    for (int k = 0; k < 2; ++k) { const int piece = lane + 64 * k, d = piece >> 1, hf = piece & 1;
                        const u32x4e vv = *(const PG8_LAS u32x4e*)(scr + d * 32 + hf * 16);
                        *(u32x4e*)(V0 + ((size_t)(b * 8 + h) * 64 + d) * S_ + s0 + hf * 8) = vv; }
                    asm volatile("s_waitcnt lgkmcnt(0)" ::: "memory"); }
        } else {
#pragma unroll
            for (int ai = 0; ai < 2; ++ai)
#pragma unroll
                for (int m = 0; m < 4; ++m) { int fr_ = fr; asm volatile("" : "+v"(fr_));
                    const int t = u.pm * BM + ai * HALF + wr * 64 + m * 16 + fr_; const int b = t / S_, s = t - b * S_;
                    f32x4 k1 = *(const f32x4*)(kr + (size_t)t * 32 + 4 * fq), k2 = *(const f32x4*)(kr + (size_t)t * 32 + 16 + 4 * fq);
                    float ss = (k1[0] * k1[0] + k1[1] * k1[1]) + (k1[2] * k1[2] + k1[3] * k1[3]) + (k2[0] * k2[0] + k2[1] * k2[1]) + (k2[2] * k2[2] + k2[3] * k2[3]);
#pragma unroll
                    for (int bj = 0; bj < 2; ++bj)
#pragma unroll
                        for (int n = 0; n < 2; ++n) { const f32x4 w = acc[ai][bj][m][n]; ss += (w[0] * w[0] + w[1] * w[1]) + (w[2] * w[2] + w[3] * w[3]); }
                    ss += __shfl_xor(ss, 16); ss += __shfl_xor(ss, 32);
                    const float rstd = 1.0f / sqrtf(ss * (1.0f / 96.0f) + EPS_);
                    bf16_t* base = K0 + ((size_t)(b * 8 + h) * S_ + s) * 96;
#pragma unroll
                    for (int bj = 0; bj < 2; ++bj)
#pragma unroll
                        for (int n = 0; n < 2; ++n) { const int c = 32 * bj + 16 * n + 4 * fq; const f32x4 w = acc[ai][bj][m][n] * *(const f32x4*)(gk + c) * rstd;
                            *(u32x2_*)(base + c) = (u32x2_){(unsigned)f2bf(w[0]) | ((unsigned)f2bf(w[1]) << 16), (unsigned)f2bf(w[2]) | ((unsigned)f2bf(w[3]) << 16)};
                            asm volatile("" ::: "memory"); }
                    k1 = k1 * *(const f32x4*)(gk + 64 + 4 * fq) * rstd; k2 = k2 * *(const f32x4*)(gk + 80 + 4 * fq) * rstd;
                    { const f32x4 cs = *(const f32x4*)(rope + (size_t)s * 16 + 4 * fq), sn = *(const f32x4*)(rope + (size_t)(S_ + s) * 16 + 4 * fq);
                      const f32x4 o1 = k1 * cs - k2 * sn; k2 = k2 * cs + k1 * sn; k1 = o1; }
                    *(u32x2_*)(base + 64 + 4 * fq) = (u32x2_){(unsigned)f2bf(k1[0]) | ((unsigned)f2bf(k1[1]) << 16), (unsigned)f2bf(k1[2]) | ((unsigned)f2bf(k1[3]) << 16)};
                    *(u32x2_*)(base + 80 + 4 * fq) = (u32x2_){(unsigned)f2bf(k2[0]) | ((unsigned)f2bf(k2[1]) << 16), (unsigned)f2bf(k2[2]) | ((unsigned)f2bf(k2[3]) << 16)};
                    asm volatile("" ::: "memory"); }
        }
    }
};

struct EpiUpRelu2Perm {
    bf16_t* out; const float* ssq;
    __device__ __forceinline__ void operator()(const f32x4 (&acc)[2][2][4][2], const Unit& u, int wr, int wc, int fr, int fq) const {
        asm volatile("" : "+v"(fr), "+v"(fq));
        float rs8[2][4]; row_rstd8(ssq, u.pm * BM + wr * 64 + fr, fq, rs8);
#pragma unroll
        for (int ai = 0; ai < 2; ++ai)
#pragma unroll
            for (int m = 0; m < 4; ++m) { const int row = u.pm * BM + ai * HALF + wr * 64 + m * 16 + fr;
                const float rstd = rs8[ai][m];
#pragma unroll
                for (int bj = 0; bj < 2; ++bj) { f32x4 v0 = acc[ai][bj][m][0] * rstd, v1 = acc[ai][bj][m][1] * rstd;
#pragma unroll
                    for (int j = 0; j < 4; ++j) { const float r0 = v0[j] > 0.f ? v0[j] : 0.f, r1 = v1[j] > 0.f ? v1[j] : 0.f; v0[j] = r0 * r0; v1[j] = r1 * r1; }
                    *(u32x4e*)(out + (size_t)row * 4096 + u.pn * BM + bj * HALF + wc * 32 + 8 * fq) = (u32x4e){(unsigned)f2bf(v0[0]) | ((unsigned)f2bf(v0[1]) << 16), (unsigned)f2bf(v0[2]) | ((unsigned)f2bf(v0[3]) << 16),
                                                                                                               (unsigned)f2bf(v1[0]) | ((unsigned)f2bf(v1[1]) << 16), (unsigned)f2bf(v1[2]) | ((unsigned)f2bf(v1[3]) << 16)}; }
                asm volatile("" ::: "memory"); }
    }
};

struct EpiStoreBf16Perm {
    bf16_t* out; int ld;
    __device__ __forceinline__ void operator()(const f32x4 (&acc)[2][2][4][2], const Unit& u, int wr, int wc, int fr, int fq) const {
        asm volatile("" : "+v"(fr), "+v"(fq));
#pragma unroll
        for (int ai = 0; ai < 2; ++ai)
#pragma unroll
            for (int m = 0; m < 4; ++m) { const int row = u.pm * BM + ai * HALF + wr * 64 + m * 16 + fr;
#pragma unroll
                for (int bj = 0; bj < 2; ++bj) { const f32x4 v0 = acc[ai][bj][m][0], v1 = acc[ai][bj][m][1];
                    *(u32x4e*)(out + (size_t)row * ld + u.pn * BM + bj * HALF + wc * 32 + 8 * fq) = (u32x4e){(unsigned)f2bf(v0[0]) | ((unsigned)f2bf(v0[1]) << 16), (unsigned)f2bf(v0[2]) | ((unsigned)f2bf(v0[3]) << 16),
                                                                                                          (unsigned)f2bf(v1[0]) | ((unsigned)f2bf(v1[1]) << 16), (unsigned)f2bf(v1[2]) | ((unsigned)f2bf(v1[3]) << 16)}; }
                asm volatile("" ::: "memory"); }
    }
};

template <class Epi, bool ALIGN_EPI = true>
__device__ __forceinline__ void gemm_phase(PG8_LAS unsigned char* lds, const Gemm g, const StaticOrder& S, const Epi& E) {
    const int tid = TIDX, wid = __builtin_amdgcn_readfirstlane(tid >> 6), lane = tid & 63, wr = wid >> 2, wc = wid & 3, fr = lane & 15, fq = lane >> 4;
    int K_ = g.K; asm volatile("" : "+s"(K_));
    const int K = K_, nt = K / BK, lda = g.lda, ldb = g.ldb;
    unsigned voffA[2], voffB[2];
#pragma unroll
    for (int i = 0; i < 2; ++i) { int R, C; stage_rc(tid * 16 + i * 8192, R, C); voffA[i] = (unsigned)(R * lda + C) * 2u; voffB[i] = (unsigned)(R * ldb + C) * 2u; }
    const size_t kstep = (size_t)(BK * 2);
    const size_t hstepA = (size_t)HALF * lda * 2, hstepB = (size_t)HALF * ldb * 2;
    const size_t tstepA = 2 * hstepA, tstepB = 2 * hstepB;
    const unsigned ldsw = (unsigned)wid * 1024u;
    const int aoff = lds_byte(wr * 64 + fr, fq * 8), boff = lds_byte(wc * 32 + fr, fq * 8);
#define PG8_SA(b, h) (((b) * 2 + (h)) * HTB)
#define PG8_SB(b, h) ((4 + (b) * 2 + (h)) * HTB)
#define PG8_STAGE(bufoff, gbase, voff) do { _Pragma("unroll") for (int _i = 0; _i < 2; ++_i) \
        __builtin_amdgcn_global_load_lds((const unsigned*)((const char*)(gbase) + (voff)[_i]), (PG8_LAS unsigned*)(lds + (bufoff) + ldsw + _i * 8192), 16, 0, 0); } while (0)
#define PG8_LDA(dst, b, h) do { _Pragma("unroll") for (int m = 0; m < 4; ++m) _Pragma("unroll") for (int k = 0; k < 2; ++k) dst[m][k] = *(const PG8_LAS bf16x8*)(lds + PG8_SA(b, h) + aoff + m * 2048 + k * 1024); } while (0)
#define PG8_LDB(dst, b, h) do { _Pragma("unroll") for (int n = 0; n < 2; ++n) _Pragma("unroll") for (int k = 0; k < 2; ++k) dst[n][k] = *(const PG8_LAS bf16x8*)(lds + PG8_SB(b, h) + boff + n * 2048 + k * 1024); } while (0)
#define PG8_MMA(ai, bj, At, Bt) do { __builtin_amdgcn_s_setprio(1); _Pragma("unroll") for (int m = 0; m < 4; ++m) _Pragma("unroll") for (int n = 0; n < 2; ++n) _Pragma("unroll") for (int k = 0; k < 2; ++k) \
        acc[ai][bj][m][n] = __builtin_amdgcn_mfma_f32_16x16x32_bf16(Bt[n][k], At[m][k], acc[ai][bj][m][n], 0, 0, 0); __builtin_amdgcn_s_setprio(0); } while (0)
#define PG8_WAIT_V(n) asm volatile("s_waitcnt vmcnt(" #n ")" ::: "memory")
#define PG8_WAIT_L(n) asm volatile("s_waitcnt lgkmcnt(" #n ")" ::: "memory")
#define PG8_BAR __builtin_amdgcn_s_barrier()
#define PG8_SCHED __builtin_amdgcn_sched_barrier(0)
    Unit cur, nxt; int ui = 0;
    if (!S.next(0, cur)) return;
    f32x4 acc[2][2][4][2];
#pragma unroll
    for (int a = 0; a < 2; ++a)
#pragma unroll
        for (int b = 0; b < 2; ++b)
#pragma unroll
            for (int m = 0; m < 4; ++m)
#pragma unroll
                for (int n = 0; n < 2; ++n) acc[a][b][m][n] = (f32x4){0.f, 0.f, 0.f, 0.f};
    bf16x8 At[4][2], B0[2][2], B1[2][2];
    const char* cA = (const char*)g.A + (size_t)cur.pm * tstepA; const char* cB = (const char*)g.Bt + (size_t)cur.pn * tstepB;
    PG8_STAGE(PG8_SB(0, 0), cB, voffB); PG8_STAGE(PG8_SB(0, 1), cB + hstepB, voffB); PG8_STAGE(PG8_SA(0, 0), cA, voffA); PG8_STAGE(PG8_SA(0, 1), cA + hstepA, voffA);
    if (wr == 1) PG8_BAR;
    PG8_WAIT_V(2); PG8_BAR;
    PG8_STAGE(PG8_SB(1, 0), cB + kstep, voffB); PG8_STAGE(PG8_SA(1, 0), cA + kstep, voffA); PG8_STAGE(PG8_SB(1, 1), cB + hstepB + kstep, voffB);
    PG8_WAIT_V(6); PG8_BAR;
    for (;;) {
        const bool has_next = S.next(ui + 1, nxt);
        const char* nA = has_next ? (const char*)g.A + (size_t)nxt.pm * tstepA : cA; const char* nB = has_next ? (const char*)g.Bt + (size_t)nxt.pn * tstepB : cB;
        for (int t = 0; t < nt; t += 2) {
            const bool last = (t == nt - 2);
            const char* a1 = cA + (size_t)(t + 1) * kstep;
            const char* a2 = last ? nA : cA + (size_t)(t + 2) * kstep; const char* b2 = last ? nB : cB + (size_t)(t + 2) * kstep;
            const char* a3 = a2 + kstep; const char* b3 = b2 + kstep;
            PG8_LDB(B0, 0, 0); PG8_LDB(B1, 0, 1); PG8_SCHED; PG8_LDA(At, 0, 0); PG8_STAGE(PG8_SA(1, 1), a1 + hstepA, voffA);
            PG8_WAIT_V(8); PG8_WAIT_L(0); PG8_BAR; PG8_MMA(0, 0, At, B0); PG8_MMA(0, 1, At, B1); PG8_BAR; PG8_SCHED;
            PG8_LDA(At, 0, 1); PG8_STAGE(PG8_SB(0, 0), b2, voffB); PG8_STAGE(PG8_SB(0, 1), b2 + hstepB, voffB); PG8_STAGE(PG8_SA(0, 0), a2, voffA);
            PG8_WAIT_V(8); PG8_WAIT_L(0); PG8_BAR; PG8_MMA(1, 0, At, B0); PG8_MMA(1, 1, At, B1); PG8_BAR; PG8_SCHED;
            PG8_LDB(B0, 1, 0); PG8_LDB(B1, 1, 1); PG8_SCHED; PG8_LDA(At, 1, 0); PG8_STAGE(PG8_SA(0, 1), a2 + hstepA, voffA);
            PG8_WAIT_V(8); PG8_WAIT_L(0); PG8_BAR; PG8_MMA(0, 0, At, B0); PG8_MMA(0, 1, At, B1); PG8_BAR; PG8_SCHED;
            PG8_LDA(At, 1, 1); PG8_STAGE(PG8_SB(1, 0), b3, voffB); PG8_STAGE(PG8_SB(1, 1), b3 + hstepB, voffB); PG8_STAGE(PG8_SA(1, 0), a3, voffA);
            PG8_WAIT_V(8); PG8_WAIT_L(0); PG8_BAR; PG8_MMA(1, 0, At, B0); PG8_MMA(1, 1, At, B1); PG8_BAR; PG8_SCHED;
        }
        if constexpr (ALIGN_EPI) { if (wr == 0) PG8_BAR; }
        { const int ln_ = (int)__builtin_amdgcn_mbcnt_hi(~0u, __builtin_amdgcn_mbcnt_lo(~0u, 0u)); E(acc, cur, wr, wc, ln_ & 15, ln_ >> 4); }
        if (!has_next) break;
#pragma unroll
        for (int a = 0; a < 2; ++a)
#pragma unroll
            for (int b = 0; b < 2; ++b)
#pragma unroll
                for (int m = 0; m < 4; ++m)
#pragma unroll
                    for (int n = 0; n < 2; ++n) acc[a][b][m][n] = (f32x4){0.f, 0.f, 0.f, 0.f};
        cur = nxt; cA = nA; cB = nB; ++ui;
        if constexpr (ALIGN_EPI) { if (wr == 1) PG8_BAR; }
    }
    PG8_WAIT_V(0);
    if constexpr (!ALIGN_EPI) { if (wr == 0) PG8_BAR; }
    PG8_BAR;
#undef PG8_SA
#undef PG8_SB
#undef PG8_STAGE
#undef PG8_LDA
#undef PG8_LDB
#undef PG8_MMA
#undef PG8_WAIT_V
#undef PG8_WAIT_L
#undef PG8_BAR
#undef PG8_SCHED
}
}
template <class F> __device__ __forceinline__ void gemm_gpu(const bf16_t* A, int lda, const bf16_t* Bt, int M, int N, int K, const F& f, int block_shift = 0, int ldb = 0) {
    pg8::Gemm g{A, Bt, M, N, K, lda, ldb ? ldb : K}; pg8::StaticOrder S; S.init(M, N, (int)gridDim.x, (int)((blockIdx.x + gridDim.x - block_shift) % gridDim.x));
    pg8::EpiElem<F> E{f};
    pg8::gemm_phase<pg8::EpiElem<F>, true>((PG8_LAS unsigned char*)g_lds, g, S, E);
}
template <class E> __device__ __forceinline__ void gemm_gpu_epi(const bf16_t* A, int lda, const bf16_t* Bt, int M, int N, int K, const E& e, int block_shift = 0, int ldb = 0) {
    pg8::Gemm g{A, Bt, M, N, K, lda, ldb ? ldb : K}; pg8::StaticOrder S; S.init(M, N, (int)gridDim.x, (int)((blockIdx.x + gridDim.x - block_shift) % gridDim.x));
    pg8::gemm_phase<E, true>((PG8_LAS unsigned char*)g_lds, g, S, e);
}
#define GEMM(A, lda, Bt, M, N, K, f) gemm_gpu(A, lda, Bt, M, N, K, f)
#endif

#ifndef CPU_EMU
#define XB_TMO      128
#define XB_XCNT(j)  (256  + 64 * (j))
#define XB_XSUB(j)  (1280 + 64 * (j))
#define XB_XGEN(j)  (2304 + 64 * (j))
#define XB_TOP      3328
#define XB_TOPGEN   3392
#define XCD_BAR_WORDS 3456
#define XB_SPIN_CAP (1u << 18)
__device__ __forceinline__ unsigned xb_ld(unsigned* p)              { return __hip_atomic_load(p, __ATOMIC_RELAXED, __HIP_MEMORY_SCOPE_AGENT); }
__device__ __forceinline__ unsigned xb_add(unsigned* p, unsigned v) { return __hip_atomic_fetch_add(p, v, __ATOMIC_RELAXED, __HIP_MEMORY_SCOPE_AGENT); }
__device__ __forceinline__ unsigned xb_xcc_id() { return (unsigned)__builtin_amdgcn_s_getreg((3 << 11) | 20) & 0xFu; }
#define XB_SPIN(cond, bar) do { unsigned _sp = 0; while (cond) { __builtin_amdgcn_s_sleep(1); \
    if ((++_sp & 255u) == 0u) { if (xb_ld(&(bar)[XB_TMO])) break; if (_sp > XB_SPIN_CAP) { atomicAdd(&(bar)[XB_TMO], 1u); break; } } } } while (0)
struct XcdBarrier { unsigned* bar; unsigned x; volatile LAS unsigned* st; };
__device__ __forceinline__ XcdBarrier xcd_barrier_post(unsigned* bar, volatile LAS unsigned* st) {
    XcdBarrier b; b.bar = bar; b.x = xb_xcc_id(); b.st = st;
    return b;
}
__device__ __forceinline__ void xcd_barrier_census(const XcdBarrier& b) { if (TIDX == 0) (void)xb_add(&b.bar[XB_XCNT(b.x)], 1u); }
__device__ __forceinline__ void xcd_barrier_complete(unsigned* bar, unsigned x, unsigned& nloc, unsigned& nx) {
    const unsigned G = gridDim.x * gridDim.y * gridDim.z;
    unsigned sum, cnt, mine, sp = 0u;
    for (;;) {
        sum = 0u; cnt = 0u; mine = 0u;
#pragma unroll
        for (unsigned j = 0; j < 16; ++j) { const unsigned c = xb_ld(&bar[XB_XCNT(j)]); sum += c; cnt += (c > 0u) ? 1u : 0u; mine = (j == x) ? c : mine; }
        if (sum == G) break;
        __builtin_amdgcn_s_sleep(1);
        if ((++sp & 255u) == 0u) { if (xb_ld(&bar[XB_TMO])) break; if (sp > XB_SPIN_CAP) { atomicAdd(&bar[XB_TMO], 1u); break; } }
    }
    nloc = mine > 0u ? mine : 1u; nx = cnt > 0u ? cnt : 1u;
}
__device__ __forceinline__ void xcd_barrier(const XcdBarrier& b) {
    asm volatile("s_waitcnt vmcnt(0)" ::: "memory");
    __syncthreads();
    if (TIDX == 0) {
        unsigned* bar = b.bar;
        __builtin_amdgcn_s_waitcnt(0);
        unsigned nloc = b.st[0], nx = b.st[1];
        if (nloc == 0u) { xcd_barrier_complete(bar, b.x, nloc, nx); b.st[0] = nloc; b.st[1] = nx; }
        const unsigned old = xb_add(&bar[XB_XSUB(b.x)], 1u);
        const unsigned gen = old / nloc;
        if (old + 1u == (gen + 1u) * nloc) {
            __builtin_amdgcn_fence(__ATOMIC_RELEASE, "agent");
            asm volatile("s_waitcnt vmcnt(0)" ::: "memory");
            const unsigned og = xb_add(&bar[XB_TOP], 1u);
            const unsigned tg = og / nx;
            if (og + 1u == (tg + 1u) * nx) xb_add(&bar[XB_TOPGEN], 1u);
            else XB_SPIN(xb_ld(&bar[XB_TOPGEN]) == tg, bar);
            __builtin_amdgcn_fence(__ATOMIC_ACQUIRE, "agent");
            xb_add(&bar[XB_XGEN(b.x)], 1u);
            asm volatile("s_waitcnt vmcnt(0)" ::: "memory");
        } else {
            XB_SPIN(xb_ld(&bar[XB_XGEN(b.x)]) == gen, bar);
            __builtin_amdgcn_fence(__ATOMIC_ACQUIRE, "agent");
            asm volatile("s_waitcnt vmcnt(0)" ::: "memory");
        }
    }
    __syncthreads();
}
constexpr int LDS_BAR_OFF = LDS_TOP - 16;
#endif

constexpr int N_PHASES = 27;
#ifdef CPU_EMU
struct XcdBarrier { int dummy; };
#endif
template <int PH> DEVFN void run_phase(const Params& p, const XcdBarrier& bar) {
    unsigned char* ws = p.ws;
    bf16_t* XN = (bf16_t*)(ws + OFF_XN);
    if constexpr (PH == 0) ph_prologue(p);
#ifdef CPU_EMU
    else if constexpr (PH == 1) GEMM(XN, 1024, (const bf16_t*)(ws + W_HYIN), T_, HYIN_P, 1024, (EStoreF32{(float*)(ws + OFF_BIG), HYIN_P, HYIN_P}));
#else
    else if constexpr (PH == 1) gemm_gpu_epi(XN, 1024, (const bf16_t*)(ws + W_HYIN), T_, HYIN_P, 1024, (pg8::EpiStoreBf16Perm{(bf16_t*)(ws + OFF_BIG), HYIN_P}));
#endif
#ifdef CPU_EMU
    else if constexpr (PH == 2) ph_l0_a(p);
    else if constexpr (PH == 3) ph_l0_b(p);
    else if constexpr (PH == 4) ph_l0_scan(p);
    else if constexpr (PH == 5) ph_l0_fix(p);
#else
    else if constexpr (PH == 2) ph_l0_a_gpu(p);
    else if constexpr (PH == 3) {
#pragma unroll 1
        for (int hf = 0; hf < 2; ++hf)
            gemm_gpu_epi((const bf16_t*)(ws + OFF_XN) + 256 * hf, 512, (const bf16_t*)(ws + W_GATE) + (size_t)512 * hf * 512 + 256 * hf, T_, 512, 256,
                (pg8::EpiGates{(const bf16_t*)(ws + OFF_XN), (float*)(ws + OFF_BIG + (size_t)T_ * 4096), p.in[I_BA], p.in[I_BX], p.in[I_LAM], 512 * hf}), 128 * hf, 512);
    }
    else if constexpr (PH == 4) {
        gemm_gpu_epi((const bf16_t*)((unsigned char*)p.out + DO_QLAT), 384, (const bf16_t*)(ws + W_UQ), T_, 768, 384, (pg8::EpiStoreBf16Perm{(bf16_t*)(ws + OFF_XN), 768}));
        gemm_gpu_epi((const bf16_t*)((unsigned char*)p.out + DO_KVLAT), 256, (const bf16_t*)(ws + W_UKV), T_, 1024, 256, (pg8::EpiMlaKV{ws, (unsigned char*)p.out, p.in[I_QNK]}));
        ph_l0_scan1_gpu(p);
    }
    else if constexpr (PH == 5) { ph_l0_scan2_gpu(p); ph_l0_attn_mfma(p); }
#endif
    else if constexpr (PH == 6) {
#ifdef CPU_EMU
        GEMM((const bf16_t*)((unsigned char*)p.out + DO_QLAT), 384, (const bf16_t*)(ws + W_UQ), T_, 768, 384, (EStoreF32{(float*)(ws + OFF_BIG), 768, 768}));
        GEMM((const bf16_t*)((unsigned char*)p.out + DO_KVLAT), 256, (const bf16_t*)(ws + W_UKV), T_, 1024, 256, (EStoreF32{(float*)(ws + OFF_BIG) + (size_t)T_ * 768, 1024, 1024}));
#endif
    }
#ifdef CPU_EMU
    else if constexpr (PH == 7) ph_l0_hn(p);
#else
    else if constexpr (PH == 7) { }
#endif
    else if constexpr (PH == 8) {
#ifdef CPU_EMU
        ph_l0_attn(p);
#endif
    }
#ifdef CPU_EMU
    else if constexpr (PH == 9) GEMM((const bf16_t*)(ws + SM_CAT), 1024, (const bf16_t*)(ws + W_HYOUT), T_, 1024, 1024, (EResAddF32{p.in[I_X], p.out, 1024}));
    else if constexpr (PH == 10) ph_norm(p, p.in[I_NMLP]);
    else if constexpr (PH == 11) GEMM(XN, 1024, (const bf16_t*)(ws + W_MLP1), T_, 4096, 1024, (ERelu2Bf16{(bf16_t*)(ws + OFF_BIG), 4096}));
    else if constexpr (PH == 12) GEMM((const bf16_t*)(ws + OFF_BIG), 4096, (const bf16_t*)(ws + W_MLP2), T_, 1024, 4096, (EResAddF32{p.out, p.out, 1024}));
    else if constexpr (PH == 13) ph_norm(p, p.in[I_NMIX] + 1024);
    else if constexpr (PH == 14) GEMM(XN, 1024, (const bf16_t*)(ws + W_NSAIN), T_, NSAIN_P, 1024, (EStoreF32{(float*)(ws + OFF_BIG), NSAIN_P, NSAIN_P}));
    else if constexpr (PH == 15) ph_l1_prep(p);
#else
    else if constexpr (PH == 9) gemm_gpu_epi((const bf16_t*)(ws + SM_CAT), 1024, (const bf16_t*)(ws + W_HYOUT), T_, 1024, 1024, (pg8::EpiResNorm<true, false>{p.in[I_X], nullptr, nullptr, XN, (float*)(ws + OFF_SSQ)}));
    else if constexpr (PH == 11) gemm_gpu_epi(XN, 1024, (const bf16_t*)(ws + W_MLP1), T_, 4096, 1024, (pg8::EpiUpRelu2Perm{(bf16_t*)(ws + OFF_BIG), (const float*)(ws + OFF_SSQ)}));
    else if constexpr (PH == 12) gemm_gpu_epi((const bf16_t*)(ws + OFF_BIG), 4096, (const bf16_t*)(ws + W_MLP2), T_, 1024, 4096, (pg8::EpiResNorm<false, false>{nullptr, XN, nullptr, XN, (float*)(ws + OFF_SSQ)}));
    else if constexpr (PH == 14) {
        gemm_gpu_epi(XN, 1024, (const bf16_t*)(ws + W_NSAIN), T_, 1024, 1024,
            (pg8::EpiNsaIn<true>{(const float*)(ws + OFF_SSQ), p.in[I_NQN], p.in[I_NKN], (bf16_t*)(ws + OFF_QN), (bf16_t*)(ws + SM_KV), (float*)(ws + SM_GATE)}));
        gemm_gpu_epi(XN, 1024, (const bf16_t*)(ws + W_NSAIN) + (size_t)1024 * 1024, T_, 1024, 1024,
            (pg8::EpiNsaIn<false>{(const float*)(ws + OFF_SSQ), p.in[I_NQN], p.in[I_NKN], (bf16_t*)(ws + OFF_QN), (bf16_t*)(ws + SM_KV), (float*)(ws + SM_GATE)}));
    }
#endif
    else if constexpr (PH == 16) {
#ifdef CPU_EMU
        const float* cb = (const float*)(ws + OFF_CBIAS);
        GEMM((const bf16_t*)(ws + SM_KV), 1024, (const bf16_t*)(ws + W_C1K), MCMP, 256, 2048, (EGeluBiasBf16{(bf16_t*)(ws + SM_HK), 256, cb}));
        GEMM((const bf16_t*)(ws + SM_KV + KVSZ), 1024, (const bf16_t*)(ws + W_C1V), MCMP, 256, 2048, (EGeluBiasBf16{(bf16_t*)(ws + SM_HV), 256, cb + 256}));
#else
#pragma unroll 1
        for (int i = 0; i < 16; ++i) { const int kv = i >> 3, sl = i & 7;
            gemm_gpu((const bf16_t*)(ws + SM_KV + (size_t)kv * KVSZ) + sl * 256, 1024, (const bf16_t*)(ws + (kv ? W_C1V : W_C1K)) + sl * 256, MCMP, 256, 256,
                     (EStoreF32{(float*)(ws + OFF_BIG + (size_t)T_ * 2048) + (size_t)i * MCMP * 256, 256, 256}), 8 * i, 2048); }
        ph_l1_win_mfma(p);
#endif
    }
    else if constexpr (PH == 17) ph_l1_ck(p);
#ifdef CPU_EMU
    else if constexpr (PH == 18) ph_l1_cattn(p);
    else if constexpr (PH == 19) ph_l1_imp(p);
    else if constexpr (PH == 20) ph_l1_topk(p);
#else
    else if constexpr (PH == 18) {
        ph_l1_cmp_mfma(p);
        if (gridDim.x == 256) { asm volatile("s_waitcnt vmcnt(0)" ::: "memory"); __syncthreads(); }
        else xcd_barrier(bar);
        ph_l1_sel_ring(p);
    }
    else if constexpr (PH == 19) { }
    else if constexpr (PH == 20) { }
#endif
    else if constexpr (PH == 21) {
#ifdef CPU_EMU
        ph_l1_selwin<true>(p);
#endif
    }
#ifdef CPU_EMU
    else if constexpr (PH == 22) GEMM((const bf16_t*)(ws + OFF_BIG + (size_t)T_ * 4096), 1024, (const bf16_t*)(ws + W_NSAOUT), T_, 1024, 1024, (EResAddF32{p.out, p.out, 1024}));
    else if constexpr (PH == 23) ph_norm(p, p.in[I_NMLP] + 1024);
    else if constexpr (PH == 24) GEMM(XN, 1024, (const bf16_t*)(ws + W_MLP1) + (size_t)4096 * 1024, T_, 4096, 1024, (ERelu2Bf16{(bf16_t*)(ws + OFF_BIG), 4096}));
#else
    else if constexpr (PH == 22) gemm_gpu_epi((const bf16_t*)(ws + OFF_BIG + (size_t)T_ * 4096), 1024, (const bf16_t*)(ws + W_NSAOUT), T_, 1024, 1024, (pg8::EpiResNorm<false, false>{nullptr, XN, nullptr, XN, (float*)(ws + OFF_SSQ)}));
    else if constexpr (PH == 24) gemm_gpu_epi(XN, 1024, (const bf16_t*)(ws + W_MLP1) + (size_t)4096 * 1024, T_, 4096, 1024, (pg8::EpiUpRelu2Perm{(bf16_t*)(ws + OFF_BIG), (const float*)(ws + OFF_SSQ)}));
#endif
#ifdef CPU_EMU
    else if constexpr (PH == 25) GEMM((const bf16_t*)(ws + OFF_BIG), 4096, (const bf16_t*)(ws + W_MLP2) + (size_t)4096 * 1024, T_, 1024, 4096, (EResAddF32{p.out, p.out, 1024}));
#else
    else if constexpr (PH == 25) gemm_gpu_epi((const bf16_t*)(ws + OFF_BIG), 4096, (const bf16_t*)(ws + W_MLP2) + (size_t)4096 * 1024, T_, 1024, 4096, (pg8::EpiResNorm<false, true>{nullptr, XN, p.out, nullptr, nullptr}));
#endif
    else if constexpr (PH == 26) { }
}

#ifndef CPU_EMU
constexpr int NTHREADS = 512;
constexpr int LDS_BYTES = LDS_TOP;
namespace cg = cooperative_groups;

constexpr int NTHREADS_ = 512;
template <int PH> __device__ __forceinline__ void run_from(const Params& p, cg::grid_group& grid, const XcdBarrier& bar) {
    if constexpr (PH < N_PHASES - 1) {
        constexpr bool empty = (PH == 6 || PH == 7 || PH == 8 || PH == 10 || PH == 13 || PH == 15 || PH == 19 || PH == 20 || PH == 21 || PH == 23);
        if constexpr (!empty) {
            if constexpr (PH == 0) {
                if (blockIdx.x == 0 && TIDX < 31) ((const float**)(p.ws + OFF_PTRS))[TIDX] = p.in[TIDX];
                if (blockIdx.x == 0) for (int i = TIDX; i < XCD_BAR_WORDS; i += NTHREADS_) bar.bar[i] = 0u;
                run_phase<PH>(p, bar);
            } else {
                Params q; q.out = p.out; q.ws = p.ws;
                const float* const* tab = (const float* const*)(p.ws + OFF_PTRS);
#pragma unroll
                for (int i = 0; i < 31; ++i) q.in[i] = tab[i];
                run_phase<PH>(q, bar);
            }
            if constexpr (PH + 1 < N_PHASES - 1) { if constexpr (PH == 0) { grid.sync(); xcd_barrier_census(bar); } else xcd_barrier(bar); }
        }
        run_from<PH + 1>(p, grid, bar);
    }
}
__global__ void __launch_bounds__(NTHREADS, 2) mega_fwd(Params p) {
    cg::grid_group grid = cg::this_grid();
    volatile LAS unsigned* st = (volatile LAS unsigned*)((LAS unsigned char*)g_lds + LDS_BAR_OFF);
    {
        const unsigned hw = (unsigned)__builtin_amdgcn_s_getreg((5 << 11) | 4) & 63u;
        if ((threadIdx.x & 63u) == 0u) ((volatile LAS int*)((LAS unsigned char*)g_lds + LDS_SLOT_OFF))[hw] = (int)(threadIdx.x >> 6);
        if (threadIdx.x == 0) { st[0] = 0u; st[1] = 0u; }
    }
    __syncthreads();
    const XcdBarrier bar = xcd_barrier_post((unsigned*)(p.ws + OFF_CTL), st);
    run_from<0>(p, grid, bar);
}

extern "C" void kernel_launch(void* const* d_in, const int* in_sizes, int n_in, void* d_out, int out_size, void* d_ws, size_t ws_size, hipStream_t stream) {
    if (n_in != 31 || out_size != T_ * D_ || ws_size < WS_NEED) { fprintf(stderr, "kernel_launch: unexpected shapes (n_in %d out %d ws %zu need %zu)\n", n_in, out_size, ws_size, (size_t)WS_NEED); return; }
    static int grid_blocks = 0;
    if (!grid_blocks) {
        int dev = 0, cus = 0, per_cu = 0;
        (void)hipGetDevice(&dev);
        (void)hipDeviceGetAttribute(&cus, hipDeviceAttributeMultiprocessorCount, dev);
        (void)hipFuncSetAttribute((const void*)mega_fwd, hipFuncAttributeMaxDynamicSharedMemorySize, LDS_BYTES);
        (void)hipOccupancyMaxActiveBlocksPerMultiprocessor(&per_cu, (const void*)mega_fwd, NTHREADS, LDS_BYTES);
        if (per_cu < 1) { fprintf(stderr, "kernel_launch: occupancy query returned %d\n", per_cu); per_cu = 1; }
        if (per_cu > 1) per_cu = 1;
        grid_blocks = cus * per_cu;
    }
    Params p{};
    for (int i = 0; i < 31; ++i) p.in[i] = (const float*)d_in[i];
    p.out = (float*)d_out; p.ws = (unsigned char*)d_ws;
    void* args[] = {&p};
    hipError_t e = hipLaunchCooperativeKernel((const void*)mega_fwd, dim3(grid_blocks), dim3(NTHREADS), args, LDS_BYTES, stream);
    if (e != hipSuccess) fprintf(stderr, "cooperative launch failed: %s (grid %d)\n", hipGetErrorString(e), grid_blocks);
}
#endif
```

```cpp
#ifndef CPU_EMU
#include <hip/hip_runtime.h>
#include <hip/hip_cooperative_groups.h>
#include <cstdio>
#include <cstdint>
#define DEVFN __device__ __forceinline__
#define HDFN __host__ __device__ __forceinline__
#define MEMFN __device__ __forceinline__
#else
#define DEVFN static inline
#define HDFN static inline
#define MEMFN inline
#endif
#include <cmath>

#ifndef BATCH
#define BATCH 4
#endif
#ifndef SEQ
#define SEQ 4096
#endif

typedef unsigned short bf16_t;
typedef float f32x4 __attribute__((ext_vector_type(4)));

constexpr int B_ = BATCH, S_ = SEQ, T_ = B_ * S_, D_ = 1024, FF_ = 4096;
constexpr int HYIN = 1696, HYIN_P = 1792, NSAIN = 1840, NSAIN_P = 2048;
constexpr int NC_ = (S_ - 32) / 16 + 1, NCP_ = S_ / 16, NSEL_ = S_ / 64, NCH_ = S_ / 64;
constexpr int MCMP = B_ * 2 * NCP_;
constexpr float EPS_ = 1e-6f;

constexpr size_t MiB = 1u << 20;
constexpr size_t OFF_CTL = 0;
constexpr size_t OFF_BOUND = 32 * 1024;
constexpr size_t OFF_BKT = 44 * 1024;
constexpr size_t OFF_PTRS = 40 * 1024;
constexpr size_t OFF_ROPE = 256 * 1024;
constexpr size_t OFF_CBIAS = 64 * 1024;
constexpr size_t OFF_SSQ = 1 * MiB;
constexpr size_t OFF_W = OFF_SSQ + (size_t)T_ * 64;
constexpr size_t W_HYIN = OFF_W;
constexpr size_t W_UQ = W_HYIN + (size_t)HYIN_P * 1024 * 2;
constexpr size_t W_UKV = W_UQ + (size_t)768 * 384 * 2;
constexpr size_t W_HYOUT = W_UKV + (size_t)1024 * 256 * 2;
constexpr size_t W_MLP1 = W_HYOUT + (size_t)1024 * 1024 * 2;
constexpr size_t W_MLP2 = W_MLP1 + (size_t)2 * 4096 * 1024 * 2;
constexpr size_t W_NSAIN = W_MLP2 + (size_t)2 * 4096 * 1024 * 2;
constexpr size_t W_C1K = W_NSAIN + (size_t)NSAIN_P * 1024 * 2;
constexpr size_t W_C1V = W_C1K + (size_t)256 * 2048 * 2;
constexpr size_t W_NSAOUT = W_C1V + (size_t)256 * 2048 * 2;
constexpr size_t W_GATE = W_NSAOUT + (size_t)1024 * 1024 * 2;
constexpr size_t OFF_XN = W_GATE + (size_t)1024 * 512 * 2;
constexpr size_t OFF_BIG = OFF_XN + (size_t)T_ * 2048;
constexpr size_t OFF_SM = OFF_BIG + (size_t)T_ * 8192;
#ifdef CPU_EMU
constexpr size_t OFF_QN = OFF_XN;
#else
constexpr size_t OFF_QN = OFF_BIG + (size_t)T_ * 6144;
#endif
constexpr size_t SM_KROPE = OFF_SM;
constexpr size_t SM_CAT = SM_KROPE + (size_t)T_ * 128;
constexpr size_t SM_SCAN = SM_CAT + (size_t)T_ * 2048;
constexpr size_t SM_L0_END = SM_SCAN + (size_t)2 * B_ * NCH_ * 512 * 4;
constexpr size_t SM_KV = OFF_SM;
constexpr size_t KVSZ = (size_t)T_ * 128 * 2;
constexpr size_t SM_GATE = SM_KV + 6 * KVSZ + 4096;
constexpr size_t SM_HK = SM_GATE + (size_t)T_ * 192;
constexpr size_t SM_HV = SM_HK + (size_t)MCMP * 512;
constexpr size_t SM_CK = SM_HV + (size_t)MCMP * 512;
constexpr size_t SM_CV = SM_CK + (size_t)MCMP * 128;
constexpr size_t SM_STAT = SM_CV + (size_t)MCMP * 128;
constexpr size_t SM_IMP = SM_STAT + (size_t)T_ * 128;
constexpr size_t SM_IDX = SM_IMP + (size_t)T_ * 2 * NSEL_ * 4;
constexpr size_t SM_L1_END = SM_IDX + (size_t)T_ * 64;
constexpr size_t WS_NEED = SM_L0_END > SM_L1_END ? SM_L0_END : SM_L1_END;
constexpr size_t DO_K0 = 0;
constexpr size_t DO_V0 = DO_K0 + (size_t)T_ * 8 * 96 * 2;
constexpr size_t DO_QLAT = DO_V0 + (size_t)T_ * 8 * 64 * 2;
constexpr size_t DO_KVLAT = DO_QLAT + (size_t)T_ * 384 * 2;
static_assert(DO_KVLAT + (size_t)T_ * 256 * 2 <= (size_t)T_ * 4096, "d_out scratch");
#if BATCH == 4 && SEQ == 4096
static_assert(WS_NEED <= 256 * MiB, "workspace map exceeds 256 MiB");
#endif

struct Params { const float* in[31]; float* out; unsigned char* ws; };
enum { I_X = 0, I_RELB, I_NMIX, I_NMLP, I_W1, I_W2, I_HYIN, I_CONVW, I_CONVB, I_WA, I_BA, I_WX, I_BX, I_LAM, I_QNORM, I_KVNORM, I_WUQ, I_WUKV,
       I_QNQ, I_QNK, I_HYOUT, I_NSAIN, I_POSK, I_C1K, I_C2K, I_POSV, I_C1V, I_C2V, I_NQN, I_NKN, I_NSAOUT };

DEVFN unsigned f2u(float f) { return __builtin_bit_cast(unsigned, f); }
DEVFN float u2f(unsigned u) { return __builtin_bit_cast(float, u); }
DEVFN bf16_t f2bf(float f) { unsigned u = f2u(f); return (bf16_t)((u + 0x7fffu + ((u >> 16) & 1u)) >> 16); }
DEVFN float bf2f(bf16_t h) { return u2f((unsigned)h << 16); }
DEVFN float sigmoidf_(float x) { return 1.0f / (1.0f + expf(-x)); }
DEVFN float gelu_tanh(float x) { return 0.5f * x * (1.0f + tanhf(0.7978845608028654f * (x + 0.044715f * x * x * x))); }
DEVFN int t5_bucket(int dist) {
    int n = dist > 0 ? dist : 0;
    if (n < 16) return n;
    float v = logf((float)n / 16.0f) / 4.1588830833596715f * 16.0f;
    int l = 16 + (int)v;
    return l < 31 ? l : 31;
}

DEVFN int vperm16(int s) { return (s & ~15) | (8 * ((s >> 2) & 1) + 4 * ((s >> 3) & 1) + (s & 3)); }
DEVFN int vperm32(int s) { return (s & ~31) | (8 * ((s >> 2) & 3) + 4 * ((s >> 4) & 1) + (s & 3)); }
constexpr float LOG2E_ = 1.4426950408889634f;

#ifdef CPU_EMU
struct dim3_ { int x; };
static thread_local dim3_ threadIdx, blockIdx;
static dim3_ blockDim, gridDim;
#endif
#ifdef CPU_EMU
#define TIDX ((int)threadIdx.x)
#else
extern __shared__ __attribute__((aligned(16))) unsigned char g_lds[];
constexpr int LDS_TOP = 148480;
constexpr int LDS_SLOT_OFF = LDS_TOP - 16 - 256;
__device__ __forceinline__ int my_tid() {
    const unsigned hw = (unsigned)__builtin_amdgcn_s_getreg((5 << 11) | 4) & 63u;
    const int slot = ((volatile __attribute__((address_space(3))) int*)((__attribute__((address_space(3))) unsigned char*)g_lds + LDS_SLOT_OFF))[hw];
    return (__builtin_amdgcn_readfirstlane(slot) << 6) | (int)__builtin_amdgcn_mbcnt_hi(~0u, __builtin_amdgcn_mbcnt_lo(~0u, 0u));
}
#define TIDX my_tid()
#endif
#define GTID ((int)(blockIdx.x * blockDim.x + TIDX))
#define GSZ ((int)(gridDim.x * blockDim.x))

template <int C>
DEVFN void norm_rows_bf16(const float* src, int lds_, const float* gain, bf16_t* dst, int ldd, int nrows) {
#ifdef CPU_EMU
    for (int r = GTID; r < nrows; r += GSZ) {
        float ss = 0.f; for (int i = 0; i < C; ++i) { float v = src[(size_t)r * lds_ + i]; ss += v * v; }
        const float rstd = 1.0f / sqrtf(ss / C + EPS_);
        for (int i = 0; i < C; ++i) dst[(size_t)r * ldd + i] = f2bf(src[(size_t)r * lds_ + i] * rstd * gain[i]);
    }
#else
    const int lane = TIDX & 63, gw = GTID >> 6, nw = GSZ >> 6;
    constexpr int PER = C / 64;
    for (int r0 = gw; r0 < nrows; r0 += 2 * nw) {
        const int r1 = r0 + nw; const bool has1 = r1 < nrows;
        float v0[PER], v1[PER]; float s0 = 0.f, s1 = 0.f;
#pragma unroll
        for (int j = 0; j < PER; ++j) { v0[j] = src[(size_t)r0 * lds_ + j * 64 + lane]; v1[j] = has1 ? src[(size_t)r1 * lds_ + j * 64 + lane] : 0.f; }
#pragma unroll
        for (int j = 0; j < PER; ++j) { s0 += v0[j] * v0[j]; s1 += v1[j] * v1[j]; }
#pragma unroll
        for (int o = 1; o < 64; o <<= 1) { s0 += __shfl_xor(s0, o); s1 += __shfl_xor(s1, o); }
        const float rs0 = 1.0f / sqrtf(s0 / C + EPS_), rs1 = 1.0f / sqrtf(s1 / C + EPS_);
#pragma unroll
        for (int j = 0; j < PER; ++j) { const float g = gain[j * 64 + lane]; dst[(size_t)r0 * ldd + j * 64 + lane] = f2bf(v0[j] * rs0 * g); if (has1) dst[(size_t)r1 * ldd + j * 64 + lane] = f2bf(v1[j] * rs1 * g); }
    }
#endif
}

typedef unsigned u32x4e __attribute__((ext_vector_type(4)));
DEVFN void transpose_cvt(const float* W, int K, int N, int Npad, bf16_t* WT, const float* gain = nullptr, int headperm = 0) {
    const int nitem = Npad * (K / 8); const int gs = GSZ;
    for (int it0 = GTID; it0 < nitem; it0 += 4 * gs) {
        float v[4][8]; int ndv[4], k8v[4];
#pragma unroll
        for (int u = 0; u < 4; ++u) { const int it = it0 + u * gs; const int nd = it % Npad, k8 = it / Npad; ndv[u] = nd; k8v[u] = k8;
            const int rho = nd & 255, r32 = nd & 31, n = headperm == 1 ? (nd & ~255) + 64 * ((rho >> 5) & 3) + 32 * (rho >> 7) + (rho & 31) : headperm == 2 ? (nd & ~31) + 8 * ((r32 & 15) >> 2) + 4 * (r32 >> 4) + (r32 & 3) : nd;
            const bool ok = it < nitem && n < N;
#pragma unroll
            for (int j = 0; j < 8; ++j) v[u][j] = ok ? W[(size_t)(k8 * 8 + j) * N + n] : 0.f; }
#pragma unroll
        for (int u = 0; u < 4; ++u) { if (it0 + u * gs >= nitem) break;
            unsigned o[4];
#pragma unroll
            for (int j = 0; j < 4; ++j) { float a = v[u][2 * j], b = v[u][2 * j + 1];
                if (gain) { a *= gain[k8v[u] * 8 + 2 * j]; b *= gain[k8v[u] * 8 + 2 * j + 1]; }
                o[j] = (unsigned)f2bf(a) | ((unsigned)f2bf(b) << 16); }
            *(u32x4e*)(WT + (size_t)ndv[u] * K + k8v[u] * 8) = (u32x4e){o[0], o[1], o[2], o[3]}; }
    }
}


#ifndef CPU_EMU
__device__ __forceinline__ void transpose_cvt_lds(const float* W, int K, int N, int Npad, bf16_t* WT, const float* gain = nullptr, bool headperm = false) {
    typedef __attribute__((address_space(3))) float lds_f;
    const int tid = TIDX, lane = tid & 63, wv = tid >> 6, gw = (int)(blockIdx.x * 8 + wv), nw = (int)gridDim.x * 8;
    lds_f* scr = (lds_f*)((__attribute__((address_space(3))) unsigned char*)g_lds) + wv * (64 * 33);
    const int nblk = Npad / 32, nitem = (K / 64) * nblk;
    for (int it = gw; it < nitem; it += nw) {
        const int kb = it / nblk, nb = it - kb * nblk, k0 = kb * 64, nd0 = nb * 32;
        const int rho = nd0 & 255, ns0 = headperm ? (nd0 & ~255) + 64 * ((rho >> 5) & 3) + 32 * (rho >> 7) : nd0;
        const int n = lane & 31; const bool inb = ns0 + n < N;
#pragma unroll 8
        for (int i = 0; i < 32; ++i) { const int kk = 2 * i + (lane >> 5); float v = inb ? W[(size_t)(k0 + kk) * N + ns0 + n] : 0.f; if (gain) v *= gain[k0 + kk]; scr[kk * 33 + n] = v; }
        asm volatile("s_waitcnt lgkmcnt(0)" ::: "memory");
        const int c = lane & 7;
#pragma unroll
        for (int j = 0; j < 4; ++j) { const int nn = (lane >> 3) + 8 * j; const lds_f* sp = scr + (8 * c) * 33 + nn;
            u32x4e o; o.x = (unsigned)f2bf(sp[0]) | ((unsigned)f2bf(sp[33]) << 16); o.y = (unsigned)f2bf(sp[66]) | ((unsigned)f2bf(sp[99]) << 16);
            o.z = (unsigned)f2bf(sp[132]) | ((unsigned)f2bf(sp[165]) << 16); o.w = (unsigned)f2bf(sp[198]) | ((unsigned)f2bf(sp[231]) << 16);
            *(u32x4e*)(WT + (size_t)(nd0 + nn) * K + k0 + 8 * c) = o; }
        asm volatile("s_waitcnt lgkmcnt(0)" ::: "memory");
    }
}
__device__ __forceinline__ void transpose_cvt_w(const float* W, int K, int N, int Npad, bf16_t* WT, const float* gain = nullptr, int headperm = 0) {
    const int lane = TIDX & 63, gw = __builtin_amdgcn_readfirstlane((int)(GTID >> 6)), nw = GSZ >> 6, l4 = lane >> 2, kq = lane & 3;
    const int nb16 = Npad / 16, nitem = nb16 * (K / 32);
    for (int it0 = gw; it0 < nitem; it0 += 4 * nw) {
        float v[4][8];
#pragma unroll
        for (int u = 0; u < 4; ++u) { const int it = it0 + u * nw; const int nd = (it % nb16) * 16 + l4, k8 = (it / nb16) * 4 + kq;
            const int rho = nd & 255, r32 = nd & 31, n = headperm == 1 ? (nd & ~255) + 64 * ((rho >> 5) & 3) + 32 * (rho >> 7) + (rho & 31) : headperm == 2 ? (nd & ~31) + 8 * ((r32 & 15) >> 2) + 4 * (r32 >> 4) + (r32 & 3) : nd;
            const bool ok = it < nitem && n < N;
#pragma unroll
            for (int j = 0; j < 8; ++j) v[u][j] = ok ? W[(size_t)(k8 * 8 + j) * N + n] : 0.f; }
#pragma unroll
        for (int u = 0; u < 4; ++u) { const int it = it0 + u * nw; if (it >= nitem) break;
            const int nd = (it % nb16) * 16 + l4, k8 = (it / nb16) * 4 + kq;
            unsigned o[4];
#pragma unroll
            for (int j = 0; j < 4; ++j) { float a = v[u][2 * j], b = v[u][2 * j + 1];
                if (gain) { a *= gain[k8 * 8 + 2 * j]; b *= gain[k8 * 8 + 2 * j + 1]; }
                o[j] = (unsigned)f2bf(a) | ((unsigned)f2bf(b) << 16); }
            *(u32x4e*)(WT + (size_t)nd * K + k8 * 8) = (u32x4e){o[0], o[1], o[2], o[3]}; }
    }
}
#define TRANSPOSE_CVT transpose_cvt_w
#else
#define TRANSPOSE_CVT transpose_cvt
#endif

DEVFN void ph_prologue(const Params& p) {
    unsigned char* ws = p.ws;
#ifdef CPU_EMU
    TRANSPOSE_CVT(p.in[I_HYIN], 1024, HYIN, HYIN_P, (bf16_t*)(ws + W_HYIN));
#else
    TRANSPOSE_CVT(p.in[I_HYIN], 1024, HYIN, HYIN_P, (bf16_t*)(ws + W_HYIN), nullptr, 2);
#endif
#ifdef CPU_EMU
    TRANSPOSE_CVT(p.in[I_WUQ], 384, 768, 768, (bf16_t*)(ws + W_UQ));
#else
    TRANSPOSE_CVT(p.in[I_WUQ], 384, 768, 768, (bf16_t*)(ws + W_UQ), nullptr, 2);
#endif
#ifdef CPU_EMU
    TRANSPOSE_CVT(p.in[I_WUKV], 256, 1024, 1024, (bf16_t*)(ws + W_UKV));
#else
    TRANSPOSE_CVT(p.in[I_WUKV], 256, 1024, 1024, (bf16_t*)(ws + W_UKV), nullptr, 1);
#endif
#ifdef CPU_EMU
    TRANSPOSE_CVT(p.in[I_HYOUT], 1024, 1024, 1024, (bf16_t*)(ws + W_HYOUT));
#else
    TRANSPOSE_CVT(p.in[I_HYOUT], 1024, 1024, 1024, (bf16_t*)(ws + W_HYOUT), nullptr, 2);
#endif
    for (int l = 0; l < 2; ++l) {
#ifdef CPU_EMU
        TRANSPOSE_CVT(p.in[I_W1] + (size_t)l * 1024 * 4096, 1024, 4096, 4096, (bf16_t*)(ws + W_MLP1) + (size_t)l * 4096 * 1024);
#else
        TRANSPOSE_CVT(p.in[I_W1] + (size_t)l * 1024 * 4096, 1024, 4096, 4096, (bf16_t*)(ws + W_MLP1) + (size_t)l * 4096 * 1024, p.in[I_NMLP] + l * 1024, 2);
#endif
#ifdef CPU_EMU
        TRANSPOSE_CVT(p.in[I_W2] + (size_t)l * 4096 * 1024, 4096, 1024, 1024, (bf16_t*)(ws + W_MLP2) + (size_t)l * 4096 * 1024);
#else
        TRANSPOSE_CVT(p.in[I_W2] + (size_t)l * 4096 * 1024, 4096, 1024, 1024, (bf16_t*)(ws + W_MLP2) + (size_t)l * 4096 * 1024, nullptr, 2);
#endif
    }
#ifdef CPU_EMU
    TRANSPOSE_CVT(p.in[I_NSAIN], 1024, NSAIN, NSAIN_P, (bf16_t*)(ws + W_NSAIN));
#else
    TRANSPOSE_CVT(p.in[I_NSAIN], 1024, NSAIN, NSAIN_P, (bf16_t*)(ws + W_NSAIN), p.in[I_NMIX] + 1024, 1);
#endif
    TRANSPOSE_CVT(p.in[I_C1K], 2048, 256, 256, (bf16_t*)(ws + W_C1K));
    TRANSPOSE_CVT(p.in[I_C1V], 2048, 256, 256, (bf16_t*)(ws + W_C1V));
#ifdef CPU_EMU
    TRANSPOSE_CVT(p.in[I_NSAOUT], 1024, 1024, 1024, (bf16_t*)(ws + W_NSAOUT));
#else
    TRANSPOSE_CVT(p.in[I_NSAOUT], 1024, 1024, 1024, (bf16_t*)(ws + W_NSAOUT), nullptr, 2);
#endif
#ifndef CPU_EMU
    {
        bf16_t* WG = (bf16_t*)(ws + W_GATE); const float *wa = p.in[I_WA], *wx = p.in[I_WX];
        for (int it = GTID; it < 1024 * 64; it += GSZ) {
            const int nd = it & 1023, k8 = it >> 10, c = nd >> 1, gsel = nd & 1, bn = c >> 6, e = c & 63;
            unsigned o[4] = {0u, 0u, 0u, 0u};
            if ((k8 >> 3) == bn) { const float* w = gsel ? wx : wa;
#pragma unroll
                for (int j = 0; j < 4; ++j) { const int d0 = (k8 & 7) * 8 + 2 * j; o[j] = (unsigned)f2bf(w[(bn * 64 + d0) * 64 + e]) | ((unsigned)f2bf(w[(bn * 64 + d0 + 1) * 64 + e]) << 16); } }
            *(u32x4e*)(WG + (size_t)nd * 512 + k8 * 8) = (u32x4e){o[0], o[1], o[2], o[3]};
        }
    }
#endif
#ifndef CPU_EMU
    if (blockIdx.x == 0 && TIDX < 64) {
        const int lane = TIDX;
        float mq0 = 0.f, mk0 = 0.f, mq1 = 0.f, mkc = 0.f, mks = 0.f, mkw = 0.f, mb = 0.f;
        for (int i = lane; i < 96; i += 64) { mq0 = fmaxf(mq0, fabsf(p.in[I_QNQ][i])); mk0 = fmaxf(mk0, fabsf(p.in[I_QNK][i])); }
        mq1 = fabsf(p.in[I_NQN][lane]); mkc = fabsf(p.in[I_NKN][lane]); mks = fabsf(p.in[I_NKN][64 + lane]); mkw = fabsf(p.in[I_NKN][128 + lane]);
        for (int i = lane; i < 512; i += 64) mb = fmaxf(mb, fabsf(p.in[I_RELB][i]));
#pragma unroll
        for (int o = 1; o < 64; o <<= 1) { mq0 = fmaxf(mq0, __shfl_xor(mq0, o)); mk0 = fmaxf(mk0, __shfl_xor(mk0, o)); mq1 = fmaxf(mq1, __shfl_xor(mq1, o)); mkc = fmaxf(mkc, __shfl_xor(mkc, o));
            mks = fmaxf(mks, __shfl_xor(mks, o)); mkw = fmaxf(mkw, __shfl_xor(mkw, o)); mb = fmaxf(mb, __shfl_xor(mb, o)); }
        if (lane == 0) { float* bd = (float*)(ws + OFF_BOUND);
            bd[0] = -(9.797958971f * mq0 * mk0 * LOG2E_ * 1.02f + 0.05f);
            bd[1] = -((8.0f * mq1 * mkc + mb) * LOG2E_ * 1.02f + 0.05f);
            bd[2] = -((8.0f * mq1 * mks + mb) * LOG2E_ * 1.02f + 0.05f);
            bd[3] = -((8.0f * mq1 * mkw + mb) * LOG2E_ * 1.02f + 0.05f); }
    }
#endif
#ifndef CPU_EMU
    for (int i = GTID; i < 4096; i += GSZ) ((unsigned char*)(ws + OFF_BKT))[i] = (unsigned char)t5_bucket(i);
    { float* rc = (float*)(ws + OFF_ROPE); float* rs = rc + (size_t)S_ * 16;
      for (int i = GTID; i < S_ * 16; i += GSZ) { const float ang = (float)(i >> 4) * powf(10000.0f, -(float)(i & 15) / 16.0f); rc[i] = cosf(ang); rs[i] = sinf(ang); } }
#endif
    float* cb = (float*)(ws + OFF_CBIAS);
#ifdef CPU_EMU
    for (int it = GTID; it < 512; it += GSZ) {
        const int kv = it >> 8, e = it & 255;
        const float* pos = p.in[kv ? I_POSV : I_POSK]; const float* w1 = p.in[kv ? I_C1V : I_C1K];
        float acc = 0.f;
        for (int k = 0; k < 2048; ++k) acc += pos[k] * w1[(size_t)k * 256 + e];
        cb[it] = acc;
    }
#else
    {
        float* part = cb + 512;
        const int lane = TIDX & 63, gw = GTID >> 6, nw = GSZ >> 6;
        for (int it = gw; it < 2 * 4 * 16; it += nw) {
            const int kv = it >> 6, cg4 = (it >> 4) & 3, ksl = it & 15, e = cg4 * 64 + lane;
            const float* pos = p.in[kv ? I_POSV : I_POSK]; const float* w1 = p.in[kv ? I_C1V : I_C1K];
            float acc = 0.f;
#pragma unroll 8
            for (int k = ksl * 128; k < ksl * 128 + 128; ++k) acc += pos[k] * w1[(size_t)k * 256 + e];
            part[ksl * 512 + kv * 256 + e] = acc;
        }
    }
#endif
    norm_rows_bf16<1024>(p.in[I_X], 1024, p.in[I_NMIX], (bf16_t*)(ws + OFF_XN), 1024, T_);
}

DEVFN void ph_l0_a(const Params& p) {
    const float* z0 = (const float*)(p.ws + OFF_BIG);
    float* xc = (float*)(p.ws + OFF_XN);
    const float* cw = p.in[I_CONVW]; const float* cbias = p.in[I_CONVB];
    for (int it = GTID; it < T_ * 512; it += GSZ) {
        const int c = it & 511, t = it >> 9, s = t % S_;
        float acc = cbias[c];
#pragma unroll
        for (int k = 0; k < 4; ++k) { const int ss = s - 3 + k; if (ss >= 0) acc += cw[k * 512 + c] * z0[(size_t)(t - 3 + k) * HYIN_P + c]; }
        xc[it] = acc;
    }
    norm_rows_bf16<384>(z0 + 1024, HYIN_P, p.in[I_QNORM], (bf16_t*)((unsigned char*)p.out + DO_QLAT), 384, T_);
    norm_rows_bf16<256>(z0 + 1408, HYIN_P, p.in[I_KVNORM], (bf16_t*)((unsigned char*)p.out + DO_KVLAT), 256, T_);
    float* kr = (float*)(p.ws + SM_KROPE);
    for (int it = GTID; it < T_ * 32; it += GSZ) kr[it] = z0[(size_t)(it >> 5) * HYIN_P + 1664 + (it & 31)];
#ifndef CPU_EMU
    { float* cb = (float*)(p.ws + OFF_CBIAS); const float* part = cb + 512;
      for (int it = GTID; it < 512; it += GSZ) { float a = 0.f; for (int k = 0; k < 16; ++k) a += part[k * 512 + it]; cb[it] = a; } }
#endif
}

DEVFN void ph_l0_b(const Params& p) {
    float* z0 = (float*)(p.ws + OFF_BIG);
    const float* xc = (const float*)(p.ws + OFF_XN);
    const float *wa = p.in[I_WA], *ba = p.in[I_BA], *wx = p.in[I_WX], *bx = p.in[I_BX], *lam = p.in[I_LAM];
    for (int it = GTID; it < T_ * 512; it += GSZ) {
        const int c = it & 511, t = it >> 9, s = t % S_, n = c >> 6, e = c & 63;
        float accA = ba[c], accX = bx[c];
        const float* xrow = xc + (size_t)t * 512 + n * 64;
        for (int d = 0; d < 64; ++d) { const float xv = xrow[d]; accA += xv * wa[(n * 64 + d) * 64 + e]; accX += xv * wx[(n * 64 + d) * 64 + e]; }
        const float r = sigmoidf_(accA), ig = sigmoidf_(accX);
        const float sp = log1pf(expf(-lam[c]));
        const float log_a = -8.0f * r * sp;
        const float a = expf(log_a);
        const float mult = (s == 0) ? 1.0f : sqrtf(-expm1f(2.0f * log_a));
        z0[(size_t)t * HYIN_P + c] = a;
        z0[(size_t)t * HYIN_P + 1024 + c] = mult * (ig * xc[it]);
    }
}

DEVFN void ph_l0_scan(const Params& p) {
    float* z0 = (float*)(p.ws + OFF_BIG);
    for (int it = GTID; it < B_ * NCH_ * 512; it += GSZ) {
        const int c = it & 511, ch = (it >> 9) % NCH_, b = it / (512 * NCH_);
        float h = 0.f, P = 1.f;
        size_t base = ((size_t)b * S_ + ch * 64) * HYIN_P + c;
        for (int j = 0; j < 64; ++j) {
            const float a = z0[base + (size_t)j * HYIN_P], bb = z0[base + (size_t)j * HYIN_P + 1024];
            h = a * h + bb; P *= a;
            z0[base + (size_t)j * HYIN_P] = P; z0[base + (size_t)j * HYIN_P + 1024] = h;
        }
    }
}

DEVFN void ph_l0_fix(const Params& p) {
    const float* z0 = (const float*)(p.ws + OFF_BIG);
    bf16_t* cat = (bf16_t*)(p.ws + SM_CAT);
    for (int it = GTID; it < B_ * NCH_ * 512; it += GSZ) {
        const int c = it & 511, ch = (it >> 9) % NCH_, b = it / (512 * NCH_);
        float carry = 0.f;
        for (int k = 0; k < ch; ++k) { const size_t tl = ((size_t)b * S_ + k * 64 + 63) * HYIN_P + c; carry = z0[tl] * carry + z0[tl + 1024]; }
        for (int j = 0; j < 64; ++j) {
            const size_t t = (size_t)b * S_ + ch * 64 + j;
            const float h = z0[t * HYIN_P + 1024 + c] + z0[t * HYIN_P + c] * carry;
            cat[t * 1024 + c] = f2bf(h * gelu_tanh(z0[t * HYIN_P + 512 + c]));
        }
    }
}


#ifndef CPU_EMU
template <int C>
__device__ __forceinline__ void norm_rows_bf16_b(const bf16_t* src, int lds_, const float* gain, bf16_t* dst, int ldd, int nrows) {
    const int lane = TIDX & 63, gw = GTID >> 6, nw = GSZ >> 6;
    constexpr int PER = C / 128;
    for (int r0 = gw; r0 < nrows; r0 += 4 * nw) {
        unsigned v[4][PER]; float ss[4];
#pragma unroll
        for (int q = 0; q < 4; ++q) { const int r = r0 + q * nw;
#pragma unroll
            for (int j = 0; j < PER; ++j) v[q][j] = r < nrows ? *(const unsigned*)(src + (size_t)r * lds_ + (j * 64 + lane) * 2) : 0u; }
#pragma unroll
        for (int q = 0; q < 4; ++q) { float a = 0.f;
#pragma unroll
            for (int j = 0; j < PER; ++j) { const float x0 = u2f(v[q][j] << 16), x1 = u2f(v[q][j] & 0xffff0000u); a += x0 * x0 + x1 * x1; }
            ss[q] = a; }
#pragma unroll
        for (int o = 1; o < 64; o <<= 1)
#pragma unroll
            for (int q = 0; q < 4; ++q) ss[q] += __shfl_xor(ss[q], o);
#pragma unroll
        for (int q = 0; q < 4; ++q) { const int r = r0 + q * nw; if (r >= nrows) break; const float rs = 1.0f / sqrtf(ss[q] / C + EPS_);
#pragma unroll
            for (int j = 0; j < PER; ++j) { const float g0 = gain[(j * 64 + lane) * 2], g1 = gain[(j * 64 + lane) * 2 + 1];
                *(unsigned*)(dst + (size_t)r * ldd + (j * 64 + lane) * 2) = (unsigned)f2bf(u2f(v[q][j] << 16) * rs * g0) | ((unsigned)f2bf(u2f(v[q][j] & 0xffff0000u) * rs * g1) << 16); } }
    }
}
__device__ __forceinline__ void ph_l0_a_gpu(const Params& p) {
    const bf16_t* z0 = (const bf16_t*)(p.ws + OFF_BIG);
    bf16_t* xc = (bf16_t*)(p.ws + OFF_XN);
    const float* cw = p.in[I_CONVW]; const float* cbias = p.in[I_CONVB];
    {
        const int gt = GTID, gs = GSZ;
        for (int it0 = gt; it0 < T_ * 64; it0 += 2 * gs) {
            u32x4e zr[2][4];
#pragma unroll
            for (int u = 0; u < 2; ++u) { const int it = it0 + u * gs; const int c = (it & 63) * 8, t = it >> 6, s = t % S_;
#pragma unroll
                for (int k = 0; k < 4; ++k) { const int ss = s - 3 + k; zr[u][k] = (it < T_ * 64 && ss >= 0) ? *(const u32x4e*)(z0 + (size_t)(t - 3 + k) * HYIN_P + c) : (u32x4e){0u, 0u, 0u, 0u}; } }
#pragma unroll
            for (int u = 0; u < 2; ++u) { const int it = it0 + u * gs; if (it >= T_ * 64) break; const int c = (it & 63) * 8, t = it >> 6;
                float a[8];
                { const f32x4 b0 = *(const f32x4*)(cbias + c), b1 = *(const f32x4*)(cbias + c + 4);
#pragma unroll
                  for (int j = 0; j < 4; ++j) { a[j] = b0[j]; a[4 + j] = b1[j]; } }
#pragma unroll
                for (int k = 0; k < 4; ++k) { const f32x4 w0 = *(const f32x4*)(cw + k * 512 + c), w1 = *(const f32x4*)(cw + k * 512 + c + 4); const u32x4e z = zr[u][k];
                    a[0] += w0[0] * u2f(z.x << 16); a[1] += w0[1] * u2f(z.x & 0xffff0000u); a[2] += w0[2] * u2f(z.y << 16); a[3] += w0[3] * u2f(z.y & 0xffff0000u);
                    a[4] += w1[0] * u2f(z.z << 16); a[5] += w1[1] * u2f(z.z & 0xffff0000u); a[6] += w1[2] * u2f(z.w << 16); a[7] += w1[3] * u2f(z.w & 0xffff0000u); }
                *(u32x4e*)(xc + (size_t)t * 512 + c) = (u32x4e){(unsigned)f2bf(a[0]) | ((unsigned)f2bf(a[1]) << 16), (unsigned)f2bf(a[2]) | ((unsigned)f2bf(a[3]) << 16),
                                                                 (unsigned)f2bf(a[4]) | ((unsigned)f2bf(a[5]) << 16), (unsigned)f2bf(a[6]) | ((unsigned)f2bf(a[7]) << 16)}; }
        }
    }
    norm_rows_bf16_b<384>(z0 + 1024, HYIN_P, p.in[I_QNORM], (bf16_t*)((unsigned char*)p.out + DO_QLAT), 384, T_);
    norm_rows_bf16_b<256>(z0 + 1408, HYIN_P, p.in[I_KVNORM], (bf16_t*)((unsigned char*)p.out + DO_KVLAT), 256, T_);
    float* kr = (float*)(p.ws + SM_KROPE);
    for (int it = GTID; it < T_ * 32; it += GSZ) kr[it] = bf2f(z0[(size_t)(it >> 5) * HYIN_P + 1664 + (it & 31)]);
    { float* cb = (float*)(p.ws + OFF_CBIAS); const float* part = cb + 512;
      for (int it = GTID; it < 512; it += GSZ) { float a = 0.f; for (int k = 0; k < 16; ++k) a += part[k * 512 + it]; cb[it] = a; } }
}
__device__ __forceinline__ void ph_l0_scan1_gpu(const Params& p) {
    const float* ab = (const float*)(p.ws + OFF_BIG + (size_t)T_ * 4096);
    float* AE = (float*)(p.ws + SM_SCAN); float* BE = AE + (size_t)B_ * NCH_ * 512;
    for (int it = GTID; it < B_ * NCH_ * 512; it += GSZ) {
        const int c = it & 511, ch = (it >> 9) % NCH_, b = it / (512 * NCH_);
        const float* base = ab + ((size_t)b * S_ + ch * 64) * 1024 + c;
        float h = 0.f, P = 1.f;
        {
            float av[64], bv[64];
#pragma unroll
            for (int k = 0; k < 64; ++k) { av[k] = base[(size_t)k * 1024]; bv[k] = base[(size_t)k * 1024 + 512]; }
#pragma unroll
            for (int k = 0; k < 64; ++k) { h = av[k] * h + bv[k]; P *= av[k]; }
        }
        AE[it] = P; BE[it] = h;
    }
}
__device__ __forceinline__ void ph_l0_scan2_gpu(const Params& p) {
    const bf16_t* z0 = (const bf16_t*)(p.ws + OFF_BIG); const float* ab = (const float*)(p.ws + OFF_BIG + (size_t)T_ * 4096);
    const float* AE = (const float*)(p.ws + SM_SCAN); const float* BE = AE + (size_t)B_ * NCH_ * 512;
    bf16_t* cat = (bf16_t*)(p.ws + SM_CAT);
    for (int it = GTID; it < B_ * NCH_ * 512; it += GSZ) {
        const int c = it & 511, ch = (it >> 9) % NCH_, b = it / (512 * NCH_);
        float h = 0.f;
        for (int k0 = 0; k0 < ch; k0 += 64) {
            float ae[64], be[64];
#pragma unroll
            for (int k = 0; k < 64; ++k) { const bool ok = k0 + k < ch; const size_t si = ((size_t)b * NCH_ + (ok ? k0 + k : 0)) * 512 + c; ae[k] = ok ? AE[si] : 1.f; be[k] = ok ? BE[si] : 0.f; }
#pragma unroll
            for (int k = 0; k < 64; ++k) h = ae[k] * h + be[k];
        }
        const size_t t0 = (size_t)b * S_ + ch * 64;
        const float* base = ab + t0 * 1024 + c; const bf16_t* gbase = z0 + t0 * HYIN_P + 512 + c;
        for (int j0 = 0; j0 < 64; j0 += 64) {
            float av[64], bv[64], gv[64];
#pragma unroll
            for (int k = 0; k < 64; ++k) { av[k] = base[(size_t)(j0 + k) * 1024]; bv[k] = base[(size_t)(j0 + k) * 1024 + 512]; gv[k] = bf2f(gbase[(size_t)(j0 + k) * HYIN_P]); }
#pragma unroll
            for (int k = 0; k < 64; ++k) { h = av[k] * h + bv[k]; cat[(t0 + j0 + k) * 1024 + c] = f2bf(h * gelu_tanh(gv[k])); }
        }
    }
}
#endif

DEVFN void ph_l0_hn(const Params& p) {
    const float* qraw = (const float*)(p.ws + OFF_BIG);
    const float* kvraw = qraw + (size_t)T_ * 768;
    const float* kr = (const float*)(p.ws + SM_KROPE);
    bf16_t* Q0 = (bf16_t*)(p.ws + OFF_XN);
    bf16_t* K0 = (bf16_t*)((unsigned char*)p.out + DO_K0);
    bf16_t* V0 = (bf16_t*)((unsigned char*)p.out + DO_V0);
    const float *gq = p.in[I_QNQ], *gk = p.in[I_QNK];
    const float scale = 0.10206207261596577f * LOG2E_;
    for (int it = GTID; it < T_ * 8 * 2; it += GSZ) {
        const int t = it % T_, h = (it / T_) & 7, isk = it / (T_ * 8);
        const int b = t / S_, s = t % S_;
        const float* src0 = isk ? kvraw + (size_t)t * 1024 + h * 128 : qraw + (size_t)t * 768 + h * 96;
        const float* src1 = isk ? kr + (size_t)t * 32 : qraw + (size_t)t * 768 + h * 96 + 64;
        float ss = 0.f;
        for (int i = 0; i < 64; ++i) { const float x = src0[i]; ss += x * x; }
        for (int i = 0; i < 32; ++i) { const float x = src1[i]; ss += x * x; }
        const float rstd = 1.0f / sqrtf(ss / 96.0f + EPS_);
        const float* g = isk ? gk : gq;
        const float sc = isk ? 1.0f : scale;
        bf16_t* dst = (isk ? K0 : Q0) + ((size_t)(b * 8 + h) * S_ + s) * 96;
        for (int i = 0; i < 64; ++i) dst[i] = f2bf(src0[i] * rstd * g[i] * sc);
        for (int i = 0; i < 16; ++i) {
            const float freq = powf(10000.0f, -(float)i / 16.0f);
            const float ang = (float)s * freq; const float cs = cosf(ang), sn = sinf(ang);
            const float x1 = src1[i] * rstd * g[64 + i], x2 = src1[16 + i] * rstd * g[80 + i];
            dst[64 + i] = f2bf((x1 * cs - x2 * sn) * sc); dst[80 + i] = f2bf((x2 * cs + x1 * sn) * sc);
        }
        if (isk) {
            bf16_t* dv = V0 + (size_t)(b * 8 + h) * 64 * S_ + vperm16(s);
            for (int i = 0; i < 64; ++i) dv[(size_t)i * S_] = f2bf(kvraw[(size_t)t * 1024 + h * 128 + 64 + i]);
        }
    }
}


#ifndef CPU_EMU
__device__ __forceinline__ void ph_l0_hn_gpu(const Params& p) {
    const float* qraw = (const float*)(p.ws + OFF_BIG);
    const float* kvraw = qraw + (size_t)T_ * 768;
    const float* kr = (const float*)(p.ws + SM_KROPE);
    bf16_t* Q0 = (bf16_t*)(p.ws + OFF_XN);
    bf16_t* K0 = (bf16_t*)((unsigned char*)p.out + DO_K0);
    bf16_t* V0 = (bf16_t*)((unsigned char*)p.out + DO_V0);
    const int tid = TIDX, lane = tid & 63, gw = (int)(blockIdx.x * 8 + (tid >> 6)), nw = (int)gridDim.x * 8;
    const float gq0 = p.in[I_QNQ][lane], gk0 = p.in[I_QNK][lane];
    const float gq1 = lane < 32 ? p.in[I_QNQ][64 + lane] : 0.f, gk1 = lane < 32 ? p.in[I_QNK][64 + lane] : 0.f;
    const float freq = powf(10000.0f, -(float)(lane & 15) / 16.0f);
    const float qscale = 0.10206207261596577f * LOG2E_;
    for (int t = gw; t < T_; t += nw) {
        const int b = t / S_, s = t - b * S_;
        float xq0[8], xq1[8], xk0[8], vv[8];
#pragma unroll
        for (int h = 0; h < 8; ++h) { xq0[h] = qraw[(size_t)t * 768 + h * 96 + lane]; xq1[h] = lane < 32 ? qraw[(size_t)t * 768 + h * 96 + 64 + lane] : 0.f;
            xk0[h] = kvraw[(size_t)t * 1024 + h * 128 + lane]; vv[h] = kvraw[(size_t)t * 1024 + h * 128 + 64 + lane]; }
        const float krv = lane < 32 ? kr[(size_t)t * 32 + lane] : 0.f;
        const float ang = (float)s * freq; const float cs = cosf(ang), sn = sinf(ang);
#pragma unroll
        for (int it = 0; it < 16; ++it) {
            const int h = it & 7, isk = it >> 3;
            const float x0 = isk ? xk0[h] : xq0[h], x1 = isk ? krv : xq1[h];
            float ss = x0 * x0 + x1 * x1;
#pragma unroll
            for (int o = 1; o < 64; o <<= 1) ss += __shfl_xor(ss, o);
            const float rstd = 1.0f / sqrtf(ss / 96.0f + EPS_);
            const float sc = isk ? 1.0f : qscale;
            const float y0 = x0 * rstd * (isk ? gk0 : gq0) * sc, y1 = x1 * rstd * (isk ? gk1 : gq1) * sc;
            const float pr = __shfl_xor(y1, 16);
            const float ro = (lane & 16) ? y1 * cs + pr * sn : y1 * cs - pr * sn;
            bf16_t* dst = (isk ? K0 : Q0) + ((size_t)(b * 8 + h) * S_ + s) * 96;
            dst[lane] = f2bf(y0);
            if (lane < 32) dst[64 + lane] = f2bf(ro);
            if (isk) V0[((size_t)(b * 8 + h) * 64 + lane) * S_ + vperm16(s)] = f2bf(vv[h]);
        }
    }
}
#endif

DEVFN void ph_l0_attn(const Params& p) {
    const bf16_t* Q0 = (const bf16_t*)(p.ws + OFF_XN);
    const bf16_t* K0 = (const bf16_t*)((const unsigned char*)p.out + DO_K0);
    const bf16_t* V0 = (const bf16_t*)((const unsigned char*)p.out + DO_V0);
    bf16_t* cat = (bf16_t*)(p.ws + SM_CAT);
    for (int it = GTID; it < T_ * 8; it += GSZ) {
        const int q = it % S_, bh = it / S_;
        float qv[96], o[64];
        const bf16_t* qp = Q0 + ((size_t)bh * S_ + q) * 96;
#pragma unroll
        for (int i = 0; i < 96; ++i) qv[i] = bf2f(qp[i]);
#pragma unroll
        for (int i = 0; i < 64; ++i) o[i] = 0.f;
        float m = -1e30f, l = 0.f;
        for (int j = 0; j <= q; ++j) {
            const bf16_t* kp = K0 + ((size_t)bh * S_ + j) * 96; const bf16_t* vp = V0 + (size_t)bh * 64 * S_ + vperm16(j);
            float s = 0.f;
#pragma unroll
            for (int i = 0; i < 96; ++i) s += qv[i] * bf2f(kp[i]);
            if (s > m) { const float cr = exp2f(m - s); l *= cr;
#pragma unroll
                for (int i = 0; i < 64; ++i) o[i] *= cr;
                m = s; }
            const float pe = exp2f(s - m); l += pe;
#pragma unroll
            for (int i = 0; i < 64; ++i) o[i] += pe * bf2f(vp[(size_t)i * S_]);
        }
        const float inv = 1.0f / l; const int b = bh >> 3, h = bh & 7;
        bf16_t* dst = cat + ((size_t)b * S_ + q) * 1024 + 512 + h * 64;
#pragma unroll
        for (int i = 0; i < 64; ++i) dst[i] = f2bf(o[i] * inv);
    }
}


#ifndef CPU_EMU
#define LAS __attribute__((address_space(3)))
typedef short bf16x8_t __attribute__((ext_vector_type(8)));
typedef float f32x16 __attribute__((ext_vector_type(16)));
typedef float f32x2_t __attribute__((ext_vector_type(2)));
typedef __bf16 bf16x2_t __attribute__((ext_vector_type(2)));
typedef unsigned u32x4_t __attribute__((ext_vector_type(4)));
__device__ __forceinline__ unsigned cvtpk(float lo, float hi) { f32x2_t v = {lo, hi}; bf16x2_t b = __builtin_convertvector(v, bf16x2_t); return __builtin_bit_cast(unsigned, b); }
#define GLD16(DST, PTR) asm volatile("global_load_dwordx4 %0, %1, off" : "=v"(DST) : "v"(PTR) : "memory")
__device__ __forceinline__ int crow(int r, int hi) { return (r & 3) + 8 * (r >> 2) + 4 * hi; }
__device__ __forceinline__ bf16x8_t pack8(const f32x16& p, int base) {
    u32x4_t w; w.x = cvtpk(p[base], p[base + 1]); w.y = cvtpk(p[base + 2], p[base + 3]); w.z = cvtpk(p[base + 4], p[base + 5]); w.w = cvtpk(p[base + 6], p[base + 7]);
    return __builtin_bit_cast(bf16x8_t, w);
}

__device__ __forceinline__ void mla_tile(LAS unsigned char* lds, int cur, int kt, const bf16x8_t (&qf)[6], f32x16& o0, f32x16& o1, float& l, float negB2, int qw0, int qg, int r, int hh) {
    constexpr int KROW = 208, VROW = 144, KT_B = 64 * KROW;
    f32x16 s0, s1;
#pragma unroll
    for (int i = 0; i < 16; ++i) { s0[i] = negB2; s1[i] = negB2; }
#pragma unroll
    for (int ks = 0; ks < 6; ++ks) {
        const bf16x8_t k0 = *(const LAS bf16x8_t*)(lds + cur + r * KROW + (16 * ks + 8 * hh) * 2);
        const bf16x8_t k1 = *(const LAS bf16x8_t*)(lds + cur + (32 + r) * KROW + (16 * ks + 8 * hh) * 2);
        s0 = __builtin_amdgcn_mfma_f32_32x32x16_bf16(k0, qf[ks], s0, 0, 0, 0);
        s1 = __builtin_amdgcn_mfma_f32_32x32x16_bf16(k1, qf[ks], s1, 0, 0, 0);
    }
    const bool need_mask = 64 * kt + 63 > qw0;
    float ls = 0.f;
    int hq = hh, qq = qg; asm volatile("" : "+v"(hq), "+v"(qq));
    if (need_mask) {
        asm volatile("" ::: "memory");
#pragma unroll
        for (int i = 0; i < 16; ++i) {
            float p0 = __builtin_amdgcn_exp2f(s0[i]), p1 = __builtin_amdgcn_exp2f(s1[i]);
            const int key = 64 * kt + crow(i, hq); if (key > qq) p0 = 0.f; if (key + 32 > qq) p1 = 0.f;
            s0[i] = p0; s1[i] = p1; ls += p0 + p1;
        }
    } else {
#pragma unroll
        for (int i = 0; i < 16; ++i) { const float p0 = __builtin_amdgcn_exp2f(s0[i]), p1 = __builtin_amdgcn_exp2f(s1[i]); s0[i] = p0; s1[i] = p1; ls += p0 + p1; }
    }
    l += ls;
    const bf16x8_t pa = pack8(s0, 0), pb = pack8(s0, 8), pc = pack8(s1, 0), pd = pack8(s1, 8);
    const LAS unsigned char* vb = lds + cur + KT_B + r * VROW + 8 * hh * 2;
#define PV_STEP(PF, SP) do { const bf16x8_t v0 = *(const LAS bf16x8_t*)(vb + (SP) * 32); const bf16x8_t v1 = *(const LAS bf16x8_t*)(vb + 32 * VROW + (SP) * 32); \
        o0 = __builtin_amdgcn_mfma_f32_32x32x16_bf16(PF, v0, o0, 0, 0, 0); o1 = __builtin_amdgcn_mfma_f32_32x32x16_bf16(PF, v1, o1, 0, 0, 0); } while (0)
    PV_STEP(pa, 0); PV_STEP(pb, 1); PV_STEP(pc, 2); PV_STEP(pd, 3);
#undef PV_STEP
}

__device__ __forceinline__ void ph_l0_attn_mfma(const Params& p) {
    constexpr int KROW = 208, VROW = 144, KT_B = 64 * KROW, VT_B = 64 * VROW, BUF_B = KT_B + VT_B;
    LAS unsigned char* lds = (LAS unsigned char*)g_lds;
    const bf16_t* Q0 = (const bf16_t*)(p.ws + OFF_XN);
    const bf16_t* K0 = (const bf16_t*)((const unsigned char*)p.out + DO_K0);
    const bf16_t* V0 = (const bf16_t*)((const unsigned char*)p.out + DO_V0);
    bf16_t* cat = (bf16_t*)(p.ws + SM_CAT);
    const int tid = TIDX, lane = tid & 63, w = __builtin_amdgcn_readfirstlane(tid >> 6), r = lane & 31, hh = lane >> 5;
    const float negB2 = ((const float*)(p.ws + OFF_BOUND))[0];
    constexpr int NQB = S_ / 256, NPAIR = B_ * 8 * (NQB / 2);
    LAS float* lsum = (LAS float*)(lds + 2 * BUF_B);
    for (int pair = blockIdx.x; pair < NPAIR; pair += gridDim.x) {
        int bh = pair / (NQB / 2), jj = pair % (NQB / 2);
        if (gridDim.x == 256 && NPAIR == 256 && NQB == 16) { const int x = pair & 7, j = pair >> 3; bh = 4 * x + (j >> 3); jj = j & 7; }
        for (int half = 0; half < 2; ++half) {
            const int qb = half ? NQB - 1 - jj : jj;
            const int q0 = qb * 256, NT = 4 * (qb + 1);
            const int qw0 = q0 + 32 * w, qg = qw0 + r;
            const bf16_t* Kg = K0 + (size_t)bh * S_ * 96;
            const bf16_t* Vg = V0 + (size_t)bh * 64 * S_;
            bf16x8_t qf[6];
            {
                const bf16_t* Qp = Q0 + ((size_t)((bh >> 3) * S_ + qg)) * 768 + (bh & 7) * 96;
                const float* gq = p.in[I_QNQ]; const float* rope = (const float*)(p.ws + OFF_ROPE);
                float x[6][8]; float ss = 0.f;
#pragma unroll
                for (int ks = 0; ks < 6; ++ks) { const bf16x8_t raw = *(const bf16x8_t*)(Qp + 16 * ks + 8 * hh);
#pragma unroll
                    for (int j = 0; j < 8; ++j) { x[ks][j] = bf2f((bf16_t)raw[j]); ss += x[ks][j] * x[ks][j]; } }
                ss += __shfl_xor(ss, 32);
                const float rstd = 1.0f / sqrtf(ss * (1.0f / 96.0f) + EPS_), sc = 0.10206207261596577f * LOG2E_;
#pragma unroll
                for (int ks = 0; ks < 6; ++ks)
#pragma unroll
                    for (int j = 0; j < 8; ++j) x[ks][j] *= rstd * gq[16 * ks + 8 * hh + j];
#pragma unroll
                for (int j = 0; j < 8; ++j) { const float cs = rope[(size_t)qg * 16 + 8 * hh + j], sn = rope[(size_t)(S_ + qg) * 16 + 8 * hh + j];
                    const float x1 = x[4][j], x2 = x[5][j]; x[4][j] = x1 * cs - x2 * sn; x[5][j] = x2 * cs + x1 * sn; }
#pragma unroll
                for (int ks = 0; ks < 6; ++ks) { u32x4_t w_; w_.x = cvtpk(x[ks][0] * sc, x[ks][1] * sc); w_.y = cvtpk(x[ks][2] * sc, x[ks][3] * sc); w_.z = cvtpk(x[ks][4] * sc, x[ks][5] * sc); w_.w = cvtpk(x[ks][6] * sc, x[ks][7] * sc);
                    qf[ks] = __builtin_bit_cast(bf16x8_t, w_); }
            }
            f32x16 o0, o1;
#pragma unroll
            for (int i = 0; i < 16; ++i) { o0[i] = 0.f; o1[i] = 0.f; }
            float l = 0.f;
            const int kc0 = tid, kc1 = tid + 512;
            const int kdst0 = (kc0 / 12) * KROW + (kc0 % 12) * 16, kdst1 = (kc1 / 12) * KROW + (kc1 % 12) * 16;
            const int vrow = tid >> 3, vch = tid & 7, vdst = KT_B + vrow * VROW + vch * 16;
            u32x4_t ak0, ak1, av, bk0, bk1, bv, ck0, ck1, cv_;
            ak1 = bk1 = ck1 = (u32x4_t){0u, 0u, 0u, 0u};
#define MLA_LOAD(T, RK0, RK1, RV) do { const unsigned char* kg_ = (const unsigned char*)Kg + (size_t)(T) * 64 * 192; RK0 = *(const u32x4_t*)(kg_ + (size_t)kc0 * 16); \
                if (tid < 256) RK1 = *(const u32x4_t*)(kg_ + (size_t)kc1 * 16); RV = *(const u32x4_t*)(Vg + (size_t)vrow * S_ + (T) * 64 + vch * 8); } while (0)
#define MLA_STORE(BUF, RK0, RK1, RV) do { *(LAS u32x4_t*)(lds + (BUF) + kdst0) = RK0; if (tid < 256) *(LAS u32x4_t*)(lds + (BUF) + kdst1) = RK1; *(LAS u32x4_t*)(lds + (BUF) + vdst) = RV; } while (0)
#define MLA_STEP(WK0, WK1, WV, IK0, IK1, IV) { if (kt + 3 < NT) MLA_LOAD(kt + 3, IK0, IK1, IV); \
                if (64 * kt <= qw0 + 31) mla_tile(lds, cur, kt, qf, o0, o1, l, negB2, qw0, qg, r, hh); \
                if (kt + 1 < NT) MLA_STORE(nxt, WK0, WK1, WV); __syncthreads(); if (++kt >= NT) break; cur = nxt; nxt = BUF_B - cur; }
            MLA_LOAD(0, ak0, ak1, av); MLA_STORE(0, ak0, ak1, av);
            if (NT > 1) MLA_LOAD(1, ak0, ak1, av);
            if (NT > 2) MLA_LOAD(2, bk0, bk1, bv);
            __syncthreads();
            int kt = 0, cur = 0, nxt = BUF_B;
            for (;;) {
                MLA_STEP(ak0, ak1, av, ck0, ck1, cv_)
                MLA_STEP(bk0, bk1, bv, ak0, ak1, av)
                MLA_STEP(ck0, ck1, cv_, bk0, bk1, bv)
            }
#undef MLA_STEP
#undef MLA_LOAD
#undef MLA_STORE
            l += __shfl_xor(l, 32);
            if (hh == 0) lsum[w * 32 + r] = l;
            __builtin_amdgcn_s_waitcnt(0xc07f);
            __builtin_amdgcn_wave_barrier();
            const int b = bh >> 3, h = bh & 7;
#pragma unroll
            for (int i = 0; i < 16; ++i) {
                const int qr = crow(i, hh); const float inv = 1.0f / lsum[w * 32 + qr];
                bf16_t* dst = cat + ((size_t)b * S_ + qw0 + qr) * 1024 + 512 + h * 64 + r;
                dst[0] = f2bf(o0[i] * inv); dst[32] = f2bf(o1[i] * inv);
            }
        }
    }
}
#endif

DEVFN void ph_norm(const Params& p, const float* gain) { norm_rows_bf16<1024>(p.out, 1024, gain, (bf16_t*)(p.ws + OFF_XN), 1024, T_); }

DEVFN void ph_l1_prep(const Params& p) {
    const float* z1 = (const float*)(p.ws + OFF_BIG);
    bf16_t* Qn = (bf16_t*)(p.ws + OFF_QN);
    bf16_t* KV = (bf16_t*)(p.ws + SM_KV);
    float* gate = (float*)(p.ws + SM_GATE);
    const float *gq = p.in[I_NQN], *gk = p.in[I_NKN];
    for (int it = GTID; it < T_ * 28; it += GSZ) {
        const int t = it % T_, u = it / T_; const int b = t / S_, s = t % S_;
        float v[64]; float ss = 0.f;
        const float* src = z1 + (size_t)t * NSAIN_P + u * 64;
#pragma unroll
        for (int i = 0; i < 64; ++i) { v[i] = src[i]; ss += v[i] * v[i]; }
        const float rstd = 1.0f / sqrtf(ss / 64.0f + EPS_);
        bf16_t* dst; const float* g = nullptr; float sc = 1.0f; size_t estride = 1;
        if (u < 16) { dst = Qn + ((size_t)(b * 16 + u) * S_ + s) * 64; g = gq; sc = 0.125f * LOG2E_; }
        else { const int x = (u - 16) >> 1, gg = (u - 16) & 1; dst = KV + (size_t)x * (KVSZ / 2) + ((size_t)(b * 2 + gg) * S_ + s) * 64;
               if (x == 2) g = gk + 64; else if (x == 4) g = gk + 128;
               if (x == 5) { dst = KV + (size_t)x * (KVSZ / 2) + (size_t)(b * 2 + gg) * 64 * S_ + vperm16(s); estride = S_; }
               if (x == 3) { dst = KV + (size_t)x * (KVSZ / 2) + (size_t)(b * 2 + gg) * 64 * S_ + vperm32(s); estride = S_; } }
#pragma unroll
        for (int i = 0; i < 64; ++i) dst[(size_t)i * estride] = f2bf(g ? v[i] * rstd * g[i] * sc : v[i]);
    }
    for (int it = GTID; it < T_ * 48; it += GSZ) gate[it] = sigmoidf_(z1[(size_t)(it / 48) * NSAIN_P + 1792 + it % 48]);
}

DEVFN void ph_l1_ck(const Params& p) {
#ifndef CPU_EMU
    {
        typedef __attribute__((address_space(3))) float lds_f;
        const float* part = (const float*)(p.ws + OFF_BIG + (size_t)T_ * 2048); const float* cb = (const float*)(p.ws + OFF_CBIAS);
        bf16_t* CK = (bf16_t*)(p.ws + SM_CK); bf16_t* CV = (bf16_t*)(p.ws + SM_CV);
        const int tid = TIDX, lane = tid & 63, wv = tid >> 6, gw = (int)(blockIdx.x * 8 + wv), nw = (int)gridDim.x * 8;
        lds_f* hs = (lds_f*)((__attribute__((address_space(3))) unsigned char*)g_lds) + wv * 256;
        for (int it = gw; it < MCMP * 2; it += nw) {
            const int row = it % MCMP, isv = it / MCMP;
            if ((row % NCP_) >= NC_) continue;
            f32x4 hsum = *(const f32x4*)(cb + isv * 256 + lane * 4);
#pragma unroll
            for (int sl = 0; sl < 8; ++sl) hsum += *(const f32x4*)(part + ((size_t)(isv * 8 + sl) * MCMP + row) * 256 + lane * 4);
#pragma unroll
            for (int j = 0; j < 4; ++j) hs[lane * 4 + j] = gelu_tanh(hsum[j]);
            asm volatile("s_waitcnt lgkmcnt(0)" ::: "memory");
            const float* w2 = p.in[isv ? I_C2V : I_C2K];
            float acc = 0.f;
#pragma unroll 32
            for (int j = 0; j < 256; ++j) acc += hs[j] * w2[j * 64 + lane];
            if (!isv) { float ss = acc * acc;
#pragma unroll
                for (int o = 1; o < 64; o <<= 1) ss += __shfl_xor(ss, o);
                const float rstd = 1.0f / sqrtf(ss / 64.0f + EPS_);
                CK[(size_t)row * 64 + lane] = f2bf(acc * rstd * p.in[I_NKN][lane]);
            } else CV[(size_t)(row / NCP_) * 64 * NCP_ + (size_t)lane * NCP_ + vperm16(row % NCP_)] = f2bf(acc);
            asm volatile("s_waitcnt lgkmcnt(0)" ::: "memory");
        }
        return;
    }
#endif
    const bf16_t* HK = (const bf16_t*)(p.ws + SM_HK); const bf16_t* HV = (const bf16_t*)(p.ws + SM_HV);
    bf16_t* CK = (bf16_t*)(p.ws + SM_CK); bf16_t* CV = (bf16_t*)(p.ws + SM_CV);
    for (int it = GTID; it < MCMP * 2; it += GSZ) {
        const int row = it % MCMP, isv = it / MCMP;
        if ((row % NCP_) >= NC_) continue;
        const bf16_t* hrow = (isv ? HV : HK) + (size_t)row * 256; const float* w2 = p.in[isv ? I_C2V : I_C2K];
        float acc[64];
#pragma unroll
        for (int e = 0; e < 64; ++e) acc[e] = 0.f;
        for (int j = 0; j < 256; ++j) { const float hv = bf2f(hrow[j]);
#pragma unroll
            for (int e = 0; e < 64; ++e) acc[e] += hv * w2[j * 64 + e]; }
        bf16_t* dst = (isv ? CV : CK) + (size_t)row * 64;
        if (!isv) { float ss = 0.f;
#pragma unroll
            for (int e = 0; e < 64; ++e) ss += acc[e] * acc[e];
            const float rstd = 1.0f / sqrtf(ss / 64.0f + EPS_);
#pragma unroll
            for (int e = 0; e < 64; ++e) dst[e] = f2bf(acc[e] * rstd * p.in[I_NKN][e]);
        } else {
            bf16_t* dt = CV + (size_t)(row / NCP_) * 64 * NCP_ + vperm16(row % NCP_);
#pragma unroll
            for (int e = 0; e < 64; ++e) dt[(size_t)e * NCP_] = f2bf(acc[e]);
        }
    }
}

DEVFN void ph_l1_cattn(const Params& p) {
    const bf16_t* Qn = (const bf16_t*)(p.ws + OFF_QN);
    const bf16_t* CK = (const bf16_t*)(p.ws + SM_CK); const bf16_t* CV = (const bf16_t*)(p.ws + SM_CV);
    const float* gate = (const float*)(p.ws + SM_GATE); const float* tab = p.in[I_RELB];
    float* stat = (float*)(p.ws + SM_STAT); float* acc_o = (float*)(p.ws + OFF_BIG);
    for (int it = GTID; it < T_ * 16; it += GSZ) {
        const int q = it % S_, bh = it / S_, b = bh >> 4, h = bh & 15, g = h >> 3;
        float qv[64], o[64];
        const bf16_t* qp = Qn + ((size_t)bh * S_ + q) * 64;
#pragma unroll
        for (int i = 0; i < 64; ++i) { qv[i] = bf2f(qp[i]); o[i] = 0.f; }
        int nvalid = q >= 31 ? (q - 31) / 16 + 1 : 0; if (nvalid > NC_) nvalid = NC_;
        float m = -1e30f, l = 0.f;
        for (int n = 0; n < nvalid; ++n) {
            const bf16_t* kp = CK + ((size_t)(b * 2 + g) * NCP_ + n) * 64; const bf16_t* vp = CV + (size_t)(b * 2 + g) * 64 * NCP_ + vperm16(n);
            float s = tab[t5_bucket(q - (16 * n + 31)) * 16 + h] * LOG2E_;
#pragma unroll
            for (int i = 0; i < 64; ++i) s += qv[i] * bf2f(kp[i]);
            if (s > m) { const float cr = exp2f(m - s); l *= cr;
#pragma unroll
                for (int i = 0; i < 64; ++i) o[i] *= cr;
                m = s; }
            const float pe = exp2f(s - m); l += pe;
#pragma unroll
            for (int i = 0; i < 64; ++i) o[i] += pe * bf2f(vp[(size_t)i * NCP_]);
        }
        stat[(size_t)it * 2] = m; stat[(size_t)it * 2 + 1] = l;
        const size_t t = (size_t)b * S_ + q;
        const float sc = nvalid > 0 ? gate[t * 48 + h * 3 + 0] / l : 0.f;
#pragma unroll
        for (int i = 0; i < 64; ++i) acc_o[t * 1024 + h * 64 + i] = o[i] * sc;
    }
}

DEVFN void ph_l1_imp(const Params& p) {
    const bf16_t* Qn = (const bf16_t*)(p.ws + OFF_QN);
    const bf16_t* CK = (const bf16_t*)(p.ws + SM_CK);
    const float* stat = (const float*)(p.ws + SM_STAT); const float* tab = p.in[I_RELB];
    float* imp = (float*)(p.ws + SM_IMP);
    for (int it = GTID; it < T_ * 2 * NSEL_; it += GSZ) {
        const int mb = it % NSEL_, q = (it / NSEL_) % S_, bg = it / (NSEL_ * S_), b = bg >> 1, g = bg & 1;
        const int cur = q >> 6;
        float score;
        if (mb > cur) score = -1.0f;
        else if (mb == 0 || mb == cur || mb == cur - 1) score = 1e4f;
        else {
            int nvalid = q >= 31 ? (q - 31) / 16 + 1 : 0; if (nvalid > NC_) nvalid = NC_;
            score = 0.f;
            for (int hh = 0; hh < 8; ++hh) {
                const int h = g * 8 + hh; const size_t si = ((size_t)(b * 16 + h) * S_ + q);
                const float m = stat[si * 2], rl = 1.0f / stat[si * 2 + 1];
                const bf16_t* qp = Qn + si * 64;
                for (int dn = -1; dn <= 3; ++dn) {
                    const int n = 4 * mb + dn; if (n < 0 || n >= nvalid) continue;
                    const bf16_t* kp = CK + ((size_t)bg * NCP_ + n) * 64;
                    float s = tab[t5_bucket(q - (16 * n + 31)) * 16 + h] * LOG2E_;
                    for (int i = 0; i < 64; ++i) s += bf2f(qp[i]) * bf2f(kp[i]);
                    score += ((dn == -1 || dn == 3) ? 0.5f : 1.0f) * exp2f(s - m) * rl;
                }
            }
        }
        imp[it] = score;
    }
}

DEVFN void ph_l1_topk(const Params& p) {
    const float* imp = (const float*)(p.ws + SM_IMP); unsigned long long* selm = (unsigned long long*)(p.ws + SM_IDX);
    for (int it = GTID; it < T_ * 2; it += GSZ) {
        float sv[8]; int si[8];
#pragma unroll
        for (int j = 0; j < 8; ++j) { sv[j] = -2.0f; si[j] = -1; }
        for (int mb = 0; mb < NSEL_; ++mb) {
            float v = imp[(size_t)it * NSEL_ + mb]; int vi = mb;
            if (v < 0.f) continue;
            bool ins = false;
#pragma unroll
            for (int j = 0; j < 8; ++j) { ins = ins || (v > sv[j]); if (ins) { const float tv = sv[j]; const int ti = si[j]; sv[j] = v; si[j] = vi; v = tv; vi = ti; } }
        }
        unsigned long long mask = 0ull;
#pragma unroll
        for (int j = 0; j < 8; ++j) if (si[j] >= 0) mask |= 1ull << si[j];
        selm[it] = mask;
    }
}

template <bool DO_WIN>
DEVFN void ph_l1_selwin(const Params& p) {
    const bf16_t* Qn = (const bf16_t*)(p.ws + OFF_QN);
    const bf16_t* KV = (const bf16_t*)(p.ws + SM_KV);
    const bf16_t *KS = KV + 2 * (KVSZ / 2), *VS = KV + 3 * (KVSZ / 2), *KW = KV + 4 * (KVSZ / 2), *VW = KV + 5 * (KVSZ / 2);
    const float* gate = (const float*)(p.ws + SM_GATE); const float* tab = p.in[I_RELB];
    const unsigned long long* selm = (const unsigned long long*)(p.ws + SM_IDX);
    float* acc_o = (float*)(p.ws + OFF_BIG); bf16_t* nsa_o = (bf16_t*)(p.ws + OFF_BIG + (size_t)T_ * 4096);
    for (int it = GTID; it < T_ * 16; it += GSZ) {
        const int q = it % S_, bh = it / S_, b = bh >> 4, h = bh & 15, g = h >> 3, bg = b * 2 + g;
        const size_t t = (size_t)b * S_ + q;
        float qv[64], o[64];
        const bf16_t* qp = Qn + ((size_t)bh * S_ + q) * 64;
#pragma unroll
        for (int i = 0; i < 64; ++i) qv[i] = bf2f(qp[i]);
        for (int br = 0; br < (DO_WIN ? 2 : 1); ++br) {
#pragma unroll
            for (int i = 0; i < 64; ++i) o[i] = 0.f;
            float m = -1e30f, l = 0.f;
            const bf16_t* Kb = (br ? KW : KS) + (size_t)bg * S_ * 64; const bf16_t* Vb = (br ? VW : VS) + (size_t)bg * S_ * 64;
            const int nseg = br ? 1 : (q >> 6) + 1;
            const unsigned long long mask = selm[(size_t)bg * S_ + q];
            for (int sg = 0; sg < nseg; ++sg) {
                int k0, k1;
                if (br) { k0 = q - 511 > 0 ? q - 511 : 0; k1 = q; }
                else { if (!((mask >> sg) & 1ull)) continue; k0 = sg * 64; k1 = k0 + 63 < q ? k0 + 63 : q; }
                for (int kpos = k0; kpos <= k1; ++kpos) {
                    const bf16_t* kp = Kb + (size_t)kpos * 64;
                    const bf16_t* vp = br ? Vb + vperm16(kpos) : Vb + vperm32(kpos); const size_t vst = (size_t)S_;
                    float s = tab[t5_bucket(q - kpos) * 16 + h] * LOG2E_;
#pragma unroll
                    for (int i = 0; i < 64; ++i) s += qv[i] * bf2f(kp[i]);
                    if (s > m) { const float cr = exp2f(m - s); l *= cr;
#pragma unroll
                        for (int i = 0; i < 64; ++i) o[i] *= cr;
                        m = s; }
                    const float pe = exp2f(s - m); l += pe;
#pragma unroll
                    for (int i = 0; i < 64; ++i) o[i] += pe * bf2f(vp[(size_t)i * vst]);
                }
            }
            const float sc = gate[t * 48 + h * 3 + 1 + br] / l;
            if (br == 0) {
#pragma unroll
                for (int i = 0; i < 64; ++i) acc_o[t * 1024 + h * 64 + i] += o[i] * sc;
            } else {
#pragma unroll
                for (int i = 0; i < 64; ++i) nsa_o[t * 1024 + h * 64 + i] = f2bf(acc_o[t * 1024 + h * 64 + i] + o[i] * sc);
            }
        }
    }
}

#ifndef CPU_EMU
__device__ __forceinline__ bool nsa_unit(int k, int& bg, int& qt) {
    constexpr int NQT = S_ / 32;
    if (gridDim.x == 256 && NQT == 128 && B_ * 2 == 8) { if (k >= 4) return false; const int j = blockIdx.x >> 3; bg = blockIdx.x & 7;
        qt = (k == 0) ? j : (k == 1) ? 63 - j : (k == 2) ? 64 + j : 127 - j; return true; }
    const int unit = blockIdx.x + k * gridDim.x; if (unit >= B_ * 2 * NQT) return false; bg = unit / NQT; qt = unit % NQT; return true;
}
__device__ __forceinline__ void ph_l1_cmp_mfma(const Params& p) {
    constexpr int KROWB = 144, CK_B = 256 * KROWB, VROWB = 528, CV_B = 64 * VROWB, SLROW = 33, SLAB_B = 8 * 64 * SLROW * 4;
    constexpr int O_CK = 0, O_CV = CK_B, O_SLAB = O_CV + CV_B, O_BKT = O_SLAB + SLAB_B, O_TABL = O_BKT + 4096, O_RLS = O_TABL + 2048;
    static_assert(O_RLS + 1024 <= 147456, "LDS budget");
    LAS unsigned char* lds = (LAS unsigned char*)g_lds;
    LAS float* slab = (LAS float*)(lds + O_SLAB);
    LAS unsigned char* bkt = lds + O_BKT;
    LAS float* tabl = (LAS float*)(lds + O_TABL);
    LAS float* rls = (LAS float*)(lds + O_RLS);
    const bf16_t* Qn = (const bf16_t*)(p.ws + OFF_QN);
    const bf16_t* CK = (const bf16_t*)(p.ws + SM_CK); const bf16_t* CV = (const bf16_t*)(p.ws + SM_CV);
    const float* gate = (const float*)(p.ws + SM_GATE); const float* tab = p.in[I_RELB];
    bf16_t* acc_o = (bf16_t*)(p.ws + OFF_BIG);
    unsigned long long* selm = (unsigned long long*)(p.ws + SM_IDX);
    const int tid = TIDX, lane = tid & 63, w = __builtin_amdgcn_readfirstlane(tid >> 6), r = lane & 31, hh = lane >> 5;
    const float negB2 = ((const float*)(p.ws + OFF_BOUND))[1];
    for (int i = tid; i < 1024; i += 512) ((LAS unsigned*)bkt)[i] = ((const unsigned*)(p.ws + OFF_BKT))[i];
    for (int i = tid; i < 512; i += 512) tabl[i] = tab[i] * LOG2E_;
    __syncthreads();
    int staged_bg = -1;
    for (int uk = 0;; ++uk) {
        int bg, qt;
        if (gridDim.x == 256 && S_ == 4096 && B_ * 2 == 8) {
            if (uk >= 4) break; const int j = blockIdx.x >> 3; bg = blockIdx.x & 7; qt = (uk == 0) ? 2 * j : (uk == 1) ? 2 * j + 1 : (uk == 2) ? 126 - 2 * j : 127 - 2 * j; }
        else if (!nsa_unit(uk, bg, qt)) break;
        const int q0 = qt * 32, b = bg >> 1, g = bg & 1, h = g * 8 + w;
        const int qg = q0 + r;
        if (bg != staged_bg) { staged_bg = bg;
          const unsigned char* ckg = (const unsigned char*)(CK + (size_t)bg * NCP_ * 64); const unsigned char* cvg = (const unsigned char*)(CV + (size_t)bg * 64 * NCP_);
#pragma unroll
          for (int j = 0; j < 4; ++j) { const int c = tid + 512 * j;
              *(LAS u32x4_t*)(lds + O_CK + (c >> 3) * KROWB + (c & 7) * 16) = *(const u32x4_t*)(ckg + (size_t)c * 16);
              *(LAS u32x4_t*)(lds + O_CV + (c >> 5) * VROWB + (c & 31) * 16) = *(const u32x4_t*)(cvg + (size_t)c * 16); } }
        for (int i = tid; i < 8 * 64 * SLROW; i += 512) slab[i] = 0.f;
        __syncthreads();
        bf16x8_t qf[4];
        { const bf16_t* Qp = Qn + ((size_t)(b * 16 + h) * S_ + qg) * 64;
#pragma unroll
          for (int ks = 0; ks < 4; ++ks) qf[ks] = *(const bf16x8_t*)(Qp + 16 * ks + 8 * hh); }
        f32x16 o0, o1;
#pragma unroll
        for (int i = 0; i < 16; ++i) { o0[i] = 0.f; o1[i] = 0.f; }
        float l = 0.f;
        const int qmax = q0 + 31; const int nvmax = qmax >= 31 ? (qmax - 31) / 16 + 1 : 0;
        const int NT = (nvmax + 63) >> 6;
        LAS float* myslab = slab + w * 64 * SLROW;
        for (int kt = 0; kt < NT; ++kt) {
            int hq = hh, rq = r; asm volatile("" : "+v"(hq), "+v"(rq));
            f32x16 s0, s1;
#pragma unroll
            for (int i = 0; i < 16; ++i) { s0[i] = negB2; s1[i] = negB2; }
#pragma unroll
            for (int ks = 0; ks < 4; ++ks) {
                const bf16x8_t k0 = *(const LAS bf16x8_t*)(lds + O_CK + (64 * kt + r) * KROWB + (16 * ks + 8 * hh) * 2);
                const bf16x8_t k1 = *(const LAS bf16x8_t*)(lds + O_CK + (64 * kt + 32 + r) * KROWB + (16 * ks + 8 * hh) * 2);
                s0 = __builtin_amdgcn_mfma_f32_32x32x16_bf16(k0, qf[ks], s0, 0, 0, 0);
                s1 = __builtin_amdgcn_mfma_f32_32x32x16_bf16(k1, qf[ks], s1, 0, 0, 0);
            }
            float ls = 0.f;
            const int dmin = q0 - (16 * (64 * kt + 63) + 31);
            if (dmin >= 0 && bkt[dmin] == 31) {
                const float bf_ = tabl[31 * 16 + h];
#pragma unroll
                for (int i = 0; i < 16; ++i) { const float p0 = __builtin_amdgcn_exp2f(s0[i] + bf_), p1 = __builtin_amdgcn_exp2f(s1[i] + bf_); s0[i] = p0; s1[i] = p1; ls += p0 + p1; }
            } else {
#pragma unroll
            for (int i = 0; i < 16; ++i) {
                const int n0 = 64 * kt + crow(i, hq);
                const int d0 = (q0 + rq) - (16 * n0 + 31), d1 = d0 - 512;
                const float b0 = tabl[(int)bkt[d0 & 4095] * 16 + h], b1 = tabl[(int)bkt[d1 & 4095] * 16 + h];
                float p0 = __builtin_amdgcn_exp2f(s0[i] + b0), p1 = __builtin_amdgcn_exp2f(s1[i] + b1);
                if (d0 < 0) p0 = 0.f;
                if (d1 < 0) p1 = 0.f;
                s0[i] = p0; s1[i] = p1; ls += p0 + p1;
                if ((i & 3) == 3) asm volatile("" ::: "memory");
            }
            }
            l += ls;
#pragma unroll
            for (int a = 0; a < 4; ++a) {
                const int m0 = 16 * kt + 2 * a + hq, m1 = m0 + 8;
                const float c0 = 0.5f * s0[4 * a + 3], c1 = 0.5f * s1[4 * a + 3];
                const float A0 = s0[4 * a] + s0[4 * a + 1] + s0[4 * a + 2] + c0, A1 = s1[4 * a] + s1[4 * a + 1] + s1[4 * a + 2] + c1;
                { LAS float* s_ = myslab + m0 * SLROW + rq; *s_ = *s_ + A0; }
                { LAS float* s_ = myslab + m1 * SLROW + rq; *s_ = *s_ + A1; }
                asm volatile("s_waitcnt lgkmcnt(0)" ::: "memory");
                { LAS float* s_ = myslab + (m0 + 1) * SLROW + rq; *s_ = *s_ + c0; }
                if (m1 + 1 < 64) { LAS float* s_ = myslab + (m1 + 1) * SLROW + rq; *s_ = *s_ + c1; }
                asm volatile("s_waitcnt lgkmcnt(0)" ::: "memory");
            }
            const bf16x8_t pa = pack8(s0, 0), pb = pack8(s0, 8), pc = pack8(s1, 0), pd = pack8(s1, 8);
            const LAS unsigned char* vb = lds + O_CV + r * VROWB + (64 * kt + 8 * hh) * 2;
#define PV_STEP(PF, SP) do { const bf16x8_t v0 = *(const LAS bf16x8_t*)(vb + (SP) * 32); const bf16x8_t v1 = *(const LAS bf16x8_t*)(vb + 32 * VROWB + (SP) * 32); \
                o0 = __builtin_amdgcn_mfma_f32_32x32x16_bf16(PF, v0, o0, 0, 0, 0); o1 = __builtin_amdgcn_mfma_f32_32x32x16_bf16(PF, v1, o1, 0, 0, 0); } while (0)
            PV_STEP(pa, 0); PV_STEP(pb, 1); PV_STEP(pc, 2); PV_STEP(pd, 3);
#undef PV_STEP
        }
        l += __shfl_xor(l, 32);
        if (hh == 0) rls[w * 32 + r] = l > 0.f ? 1.0f / l : 0.f;
        __syncthreads();
        {
            float gsc[16];
#pragma unroll
            for (int i = 0; i < 16; ++i) { const int qr = crow(i, hh); gsc[i] = gate[((size_t)b * S_ + q0 + qr) * 48 + h * 3 + 0] * rls[w * 32 + qr]; }
            float pa0[16], pa1[16];
#pragma unroll
            for (int i = 0; i < 16; ++i) { const size_t o = ((size_t)b * S_ + q0 + crow(i, hh)) * 1024 + h * 64 + r; pa0[i] = bf2f(acc_o[o]); pa1[i] = bf2f(acc_o[o + 32]); }
#pragma unroll
            for (int i = 0; i < 16; ++i) { const size_t o = ((size_t)b * S_ + q0 + crow(i, hh)) * 1024 + h * 64 + r; acc_o[o] = f2bf(pa0[i] + o0[i] * gsc[i]); acc_o[o + 32] = f2bf(pa1[i] + o1[i] * gsc[i]); }
        }
#pragma unroll
        for (int j = 0; j < 4; ++j) {
            int m = lane; asm volatile("" : "+v"(m));
            const int qi = 4 * w + j, q = q0 + qi, cur = q >> 6;
            float imp = 0.f;
#pragma unroll
            for (int ww = 0; ww < 8; ++ww) imp += slab[(ww * 64 + m) * SLROW + qi] * rls[ww * 32 + qi];
            const bool valid = m <= cur, forced = (m == 0) || (m == cur) || (m == cur - 1);
            const float score = !valid ? -1.0f : (forced ? 1e4f : imp);
            int rank = 0;
#pragma unroll 8
            for (int mm = 0; mm < 64; ++mm) { const float sj = __builtin_bit_cast(float, __builtin_amdgcn_readlane(__builtin_bit_cast(int, score), mm)); rank += (sj > score || (sj == score && mm < m)) ? 1 : 0; }
            const unsigned long long mask = __ballot(valid && rank < 8);
            if (lane == 0) selm[(size_t)bg * S_ + q] = mask;
        }
        __syncthreads();
    }
}
#endif

#ifndef CPU_EMU
typedef float f32x4_t __attribute__((ext_vector_type(4)));
constexpr int SEL_NPP = 4, SEL_NQW = 2 * SEL_NPP, SEL_UQ = 8 * SEL_NQW;
__device__ __forceinline__ void sel_block(LAS unsigned char* lds, int cb, int m, const unsigned long long (&mk4)[SEL_NQW], const bf16x8_t (&qf)[SEL_NPP][2], f32x4_t (&oacc)[SEL_NPP][4], float (&lsum)[SEL_NPP],
                                          float negB2, int q0, int w, int g, int hd, int kg, const LAS unsigned char* bkt, const LAS float* tabl) {
    constexpr int ROWB = 160, TILE_B = 64 * ROWB;
#pragma unroll
    for (int pp = 0; pp < SEL_NPP; ++pp) {
        const bool selA = (mk4[2 * pp] >> m) & 1ull, selB = (mk4[2 * pp + 1] >> m) & 1ull;
        if (selA || selB) {
            const int qA = q0 + SEL_NQW * w + 2 * pp, q = qA + (hd >> 3);
            const bool mine = (hd & 8) ? selB : selA;
            f32x4_t st[4];
#pragma unroll
            for (int t16 = 0; t16 < 4; ++t16) {
                f32x4_t a = (f32x4_t){negB2, negB2, negB2, negB2};
#pragma unroll
                for (int ks = 0; ks < 2; ++ks) {
                    const bf16x8_t kf = *(const LAS bf16x8_t*)(lds + cb + (16 * t16 + hd) * ROWB + (32 * ks + 8 * kg) * 2);
                    a = __builtin_amdgcn_mfma_f32_16x16x32_bf16(kf, qf[pp][ks], a, 0, 0, 0);
                }
                st[t16] = a;
            }
            float ls = 0.f;
            const int dmin = qA - (64 * m + 63);
            if (dmin >= 0 && bkt[dmin] == 31) {
                const float bf_ = tabl[31 * 16 + g * 8 + (hd & 7)];
#pragma unroll
                for (int t16 = 0; t16 < 4; ++t16)
#pragma unroll
                    for (int rg = 0; rg < 4; ++rg) { float pe = __builtin_amdgcn_exp2f(st[t16][rg] + bf_); if (!mine) pe = 0.f; st[t16][rg] = pe; ls += pe; }
            } else {
#pragma unroll
                for (int t16 = 0; t16 < 4; ++t16)
#pragma unroll
                    for (int rg = 0; rg < 4; ++rg) {
                        const int d = q - (64 * m + 16 * t16 + 4 * kg + rg);
                        const float bb = tabl[(int)bkt[d & 4095] * 16 + g * 8 + (hd & 7)];
                        float pe = __builtin_amdgcn_exp2f(st[t16][rg] + bb);
                        if (d < 0 || !mine) pe = 0.f;
                        st[t16][rg] = pe; ls += pe;
                    }
            }
            lsum[pp] += ls;
#pragma unroll
            for (int kp = 0; kp < 2; ++kp) {
                u32x4_t pw; pw.x = cvtpk(st[2 * kp][0], st[2 * kp][1]); pw.y = cvtpk(st[2 * kp][2], st[2 * kp][3]);
                pw.z = cvtpk(st[2 * kp + 1][0], st[2 * kp + 1][1]); pw.w = cvtpk(st[2 * kp + 1][2], st[2 * kp + 1][3]);
                const bf16x8_t pf = __builtin_bit_cast(bf16x8_t, pw);
#pragma unroll
                for (int dt = 0; dt < 4; ++dt) {
                    const bf16x8_t vf = *(const LAS bf16x8_t*)(lds + cb + TILE_B + (16 * dt + hd) * ROWB + (32 * kp + 8 * kg) * 2);
                    oacc[pp][dt] = __builtin_amdgcn_mfma_f32_16x16x32_bf16(vf, pf, oacc[pp][dt], 0, 0, 0);
                }
            }
        }
    }
}


__device__ __forceinline__ void ph_l1_sel_mfma(const Params& p) {
    constexpr int ROWB = 160, TILE_B = 64 * ROWB, BLK_B = 2 * TILE_B, BUF_B = 2 * BLK_B;
    constexpr int O_BKT = 2 * BUF_B, O_TABL = O_BKT + 4096;
    LAS unsigned char* lds = (LAS unsigned char*)g_lds;
    LAS unsigned char* bkt = lds + O_BKT; LAS float* tabl = (LAS float*)(lds + O_TABL);
    const bf16_t* Qn = (const bf16_t*)(p.ws + OFF_QN);
    const bf16_t* KV = (const bf16_t*)(p.ws + SM_KV);
    const bf16_t *KS = KV + 2 * (KVSZ / 2), *VS = KV + 3 * (KVSZ / 2);
    const float* gate = (const float*)(p.ws + SM_GATE); const float* tab = p.in[I_RELB];
    const unsigned long long* selm = (const unsigned long long*)(p.ws + SM_IDX);
    const bf16_t* acc_o = (const bf16_t*)(p.ws + OFF_BIG); bf16_t* nsa_o = (bf16_t*)(p.ws + OFF_BIG + (size_t)T_ * 4096);
    const int tid = TIDX, lane = tid & 63, w = __builtin_amdgcn_readfirstlane(tid >> 6), hd = lane & 15, kg = lane >> 4;
    const float negB2 = ((const float*)(p.ws + OFF_BOUND))[2];
    for (int i = tid; i < 1024; i += 512) ((LAS unsigned*)bkt)[i] = ((const unsigned*)(p.ws + OFF_BKT))[i];
    for (int i = tid; i < 512; i += 512) tabl[i] = tab[i] * LOG2E_;
    __syncthreads();
    for (int uk = 0;; ++uk) {
        constexpr int NU = S_ / SEL_UQ;
        int bg, qt;
        if (gridDim.x == 256 && NU == 64 && B_ * 2 == 8) { if (uk >= 2) break; const int j = blockIdx.x >> 3; bg = blockIdx.x & 7; qt = uk ? NU - 1 - j : j; }
        else { const int unit = blockIdx.x + uk * gridDim.x; if (unit >= B_ * 2 * NU) break; bg = unit / NU; qt = unit % NU; }
        const int q0 = qt * SEL_UQ, b = bg >> 1, g = bg & 1, cur = q0 >> 6;
        unsigned long long U = 0ull;
        for (int j = 0; j < SEL_UQ; ++j) U |= __hip_atomic_load(selm + (size_t)bg * S_ + q0 + j, __ATOMIC_RELAXED, __HIP_MEMORY_SCOPE_AGENT);
        unsigned long long mk4[SEL_NQW];
#pragma unroll
        for (int j = 0; j < SEL_NQW; ++j) { const unsigned long long v = __hip_atomic_load(selm + (size_t)bg * S_ + q0 + SEL_NQW * w + j, __ATOMIC_RELAXED, __HIP_MEMORY_SCOPE_AGENT);
            mk4[j] = ((unsigned long long)(unsigned)__builtin_amdgcn_readfirstlane((unsigned)(v >> 32)) << 32) | (unsigned long long)(unsigned)__builtin_amdgcn_readfirstlane((unsigned)v); }
        U = ((unsigned long long)(unsigned)__builtin_amdgcn_readfirstlane((unsigned)(U >> 32)) << 32) | (unsigned long long)(unsigned)__builtin_amdgcn_readfirstlane((unsigned)U);
        bf16x8_t qf[SEL_NPP][2];
#pragma unroll
        for (int pp = 0; pp < SEL_NPP; ++pp)
#pragma unroll
            for (int ks = 0; ks < 2; ++ks)
                qf[pp][ks] = *(const bf16x8_t*)(Qn + ((size_t)(b * 16 + g * 8 + (hd & 7)) * S_ + q0 + SEL_NQW * w + 2 * pp + (hd >> 3)) * 64 + 32 * ks + 8 * kg);
        f32x4_t oacc[SEL_NPP][4]; float lsum[SEL_NPP];
#pragma unroll
        for (int pp = 0; pp < SEL_NPP; ++pp) { lsum[pp] = 0.f;
#pragma unroll
            for (int dt = 0; dt < 4; ++dt) oacc[pp][dt] = (f32x4_t){0.f, 0.f, 0.f, 0.f}; }
        const bf16_t* Kg = KS + (size_t)bg * S_ * 64;
        const bf16_t* Vg = VS + (size_t)bg * 64 * S_;
        const int srow = tid >> 3, sch = tid & 7, kdst = srow * ROWB + sch * 16, vdst = TILE_B + kdst;
        u32x4_t a0, a1, a2, a3, b0_, b1_, b2_, b3_;
        int ia0 = 0, ia1 = -1, ib0 = 0, ib1 = -1;
        unsigned long long rem = U;
#define SEL_NEXT(I0, I1) do { I0 = __builtin_ctzll(rem); rem &= rem - 1; I1 = -1; if (rem) { I1 = __builtin_ctzll(rem); rem &= rem - 1; } } while (0)
#define SEL_LOAD(I0, I1, R0, R1, R2, R3) do { const int i1_ = (I1) < 0 ? (I0) : (I1); GLD16(R0, Kg + (size_t)((I0) * 64 + srow) * 64 + sch * 8); GLD16(R1, Vg + (size_t)srow * S_ + (I0) * 64 + sch * 8); \
            GLD16(R2, Kg + (size_t)(i1_ * 64 + srow) * 64 + sch * 8); GLD16(R3, Vg + (size_t)srow * S_ + i1_ * 64 + sch * 8); } while (0)
#define SEL_WAIT(N, R0, R1, R2, R3) asm volatile("s_waitcnt vmcnt(" #N ")" : "+v"(R0), "+v"(R1), "+v"(R2), "+v"(R3) :: "memory")
#define SEL_STORE(BUF, R0, R1, R2, R3) do { *(LAS u32x4_t*)(lds + (BUF) + kdst) = R0; *(LAS u32x4_t*)(lds + (BUF) + vdst) = R1; *(LAS u32x4_t*)(lds + (BUF) + BLK_B + kdst) = R2; *(LAS u32x4_t*)(lds + (BUF) + BLK_B + vdst) = R3; } while (0)
#pragma unroll
        for (int pp = 0; pp < SEL_NPP; ++pp) asm volatile("" : "+v"(qf[pp][0]), "+v"(qf[pp][1]));
        asm volatile("s_waitcnt vmcnt(0)" ::: "memory");
        int m0, m1; SEL_NEXT(m0, m1);
        SEL_LOAD(m0, m1, a0, a1, a2, a3); SEL_WAIT(0, a0, a1, a2, a3); SEL_STORE(0, a0, a1, a2, a3);
        bool has1 = rem != 0ull;
        if (has1) { SEL_NEXT(ia0, ia1); SEL_LOAD(ia0, ia1, a0, a1, a2, a3); }
        __syncthreads();
        int cb = 0, nb = BUF_B;
#define SEL_STEP(IW0, IW1, W0, W1, W2, W3, II0, II1, I0, I1, I2, I3) { const bool hasI = has1 && rem != 0ull; if (hasI) { SEL_NEXT(II0, II1); SEL_LOAD(II0, II1, I0, I1, I2, I3); } \
            sel_block(lds, cb, m0, mk4, qf, oacc, lsum, negB2, q0, w, g, hd, kg, bkt, tabl); \
            if (m1 >= 0) sel_block(lds, cb + BLK_B, m1, mk4, qf, oacc, lsum, negB2, q0, w, g, hd, kg, bkt, tabl); \
            if (has1) { if (hasI) SEL_WAIT(4, W0, W1, W2, W3); else SEL_WAIT(0, W0, W1, W2, W3); SEL_STORE(nb, W0, W1, W2, W3); } \
            __syncthreads(); if (!has1) break; m0 = IW0; m1 = IW1; has1 = hasI; cb = nb; nb = BUF_B - cb; }
        for (;;) {
            SEL_STEP(ia0, ia1, a0, a1, a2, a3, ib0, ib1, b0_, b1_, b2_, b3_)
            SEL_STEP(ib0, ib1, b0_, b1_, b2_, b3_, ia0, ia1, a0, a1, a2, a3)
        }
#undef SEL_STEP
#undef SEL_LOAD
#undef SEL_WAIT
#undef SEL_STORE
#undef SEL_NEXT
        {
            typedef unsigned u32x2s __attribute__((ext_vector_type(2)));
#pragma unroll
            for (int pp = 0; pp < SEL_NPP; ++pp) { float l = lsum[pp]; l += __shfl_xor(l, 16); l += __shfl_xor(l, 32);
                const size_t t = (size_t)b * S_ + q0 + SEL_NQW * w + 2 * pp + (hd >> 3); const int h = g * 8 + (hd & 7);
                const float sc = gate[t * 48 + h * 3 + 1] / l;
                u32x2s prev[4];
#pragma unroll
                for (int dt = 0; dt < 4; ++dt) { const unsigned long long pv_ = __hip_atomic_load((const unsigned long long*)(acc_o + t * 1024 + h * 64 + 16 * dt + 4 * kg), __ATOMIC_RELAXED, __HIP_MEMORY_SCOPE_AGENT); prev[dt] = (u32x2s){(unsigned)pv_, (unsigned)(pv_ >> 32)}; }
#pragma unroll
                for (int dt = 0; dt < 4; ++dt) { const f32x4_t a = oacc[pp][dt] * sc;
                    const float v0 = u2f(prev[dt].x << 16) + a[0], v1 = u2f(prev[dt].x & 0xffff0000u) + a[1], v2 = u2f(prev[dt].y << 16) + a[2], v3 = u2f(prev[dt].y & 0xffff0000u) + a[3];
                    *(u32x2s*)(nsa_o + t * 1024 + h * 64 + 16 * dt + 4 * kg) = (u32x2s){(unsigned)f2bf(v0) | ((unsigned)f2bf(v1) << 16), (unsigned)f2bf(v2) | ((unsigned)f2bf(v3) << 16)}; }
                asm volatile("" ::: "memory");
            }
        }
        (void)cur;
    }
}
__device__ __forceinline__ void sel_block_sw(LAS unsigned char* lds, int cb, int m, const unsigned long long (&mk4)[SEL_NQW], const bf16x8_t (&qf)[SEL_NPP][2], f32x4_t (&oacc)[SEL_NPP][4], float (&lsum)[SEL_NPP],
                                          float negB2, int q0, int w, int g, int hd, int kg, const LAS unsigned char* bkt, const LAS float* tabl, float bfar) {
    constexpr int ROWB = 128, TILE_B = 64 * ROWB;
    const int swz = (kg ^ (hd & 7)) << 4;
#pragma unroll
    for (int pp = 0; pp < SEL_NPP; ++pp) {
        const bool selA = (mk4[2 * pp] >> m) & 1ull, selB = (mk4[2 * pp + 1] >> m) & 1ull;
        if (selA || selB) {
            const int qA = q0 + SEL_NQW * w + 2 * pp, q = qA + (hd >> 3);
            const bool mine = (hd & 8) ? selB : selA;
            f32x4_t st[4];
#pragma unroll
            for (int t16 = 0; t16 < 4; ++t16) {
                f32x4_t a = (f32x4_t){negB2, negB2, negB2, negB2};
#pragma unroll
                for (int ks = 0; ks < 2; ++ks) {
                    const bf16x8_t kf = *(const LAS bf16x8_t*)(lds + cb + (16 * t16 + hd) * ROWB + (swz ^ (64 * ks)));
                    a = __builtin_amdgcn_mfma_f32_16x16x32_bf16(kf, qf[pp][ks], a, 0, 0, 0);
                }
                st[t16] = a;
            }
            float ls = 0.f;
            const float mneg = mine ? 0.f : -1.0e30f;
            const int dmin = qA - (64 * m + 63);
            if (dmin >= 1024 || (dmin >= 0 && bkt[dmin] == 31)) {
                const float bf_ = bfar + mneg;
#pragma unroll
                for (int t16 = 0; t16 < 4; ++t16)
#pragma unroll
                    for (int rg = 0; rg < 4; ++rg) { const float pe = __builtin_amdgcn_exp2f(st[t16][rg] + bf_); st[t16][rg] = pe; ls += pe; }
            } else {
#pragma unroll
                for (int t16 = 0; t16 < 4; ++t16)
#pragma unroll
                    for (int rg = 0; rg < 4; ++rg) {
                        const int d = q - (64 * m + 16 * t16 + 4 * kg + rg);
                        const float bb = tabl[(int)bkt[d & 4095] * 16 + g * 8 + (hd & 7)] + mneg;
                        const float pe = __builtin_amdgcn_exp2f(st[t16][rg] + bb);
                        st[t16][rg] = pe; ls += pe;
                    }
            }
            lsum[pp] += ls;
#pragma unroll
            for (int kp = 0; kp < 2; ++kp) {
                u32x4_t pw; pw.x = cvtpk(st[2 * kp][0], st[2 * kp][1]); pw.y = cvtpk(st[2 * kp][2], st[2 * kp][3]);
                pw.z = cvtpk(st[2 * kp + 1][0], st[2 * kp + 1][1]); pw.w = cvtpk(st[2 * kp + 1][2], st[2 * kp + 1][3]);
                const bf16x8_t pf = __builtin_bit_cast(bf16x8_t, pw);
#pragma unroll
                for (int dt = 0; dt < 4; ++dt) {
                    const bf16x8_t vf = *(const LAS bf16x8_t*)(lds + cb + TILE_B + (16 * dt + hd) * ROWB + (swz ^ (64 * kp)));
                    oacc[pp][dt] = __builtin_amdgcn_mfma_f32_16x16x32_bf16(vf, pf, oacc[pp][dt], 0, 0, 0);
                }
            }
        }
    }
}


__device__ __forceinline__ unsigned ring_min8(const LAS unsigned* c8) {
    const u32x4_t a = *(const volatile LAS u32x4_t*)c8, b = *(const volatile LAS u32x4_t*)(c8 + 4);
    unsigned m0 = a.x < a.y ? a.x : a.y, m1 = a.z < a.w ? a.z : a.w, m2 = b.x < b.y ? b.x : b.y, m3 = b.z < b.w ? b.z : b.w;
    m0 = m0 < m1 ? m0 : m1; m2 = m2 < m3 ? m2 : m3; m0 = m0 < m2 ? m0 : m2;
    return (unsigned)__builtin_amdgcn_readfirstlane((int)m0);
}
__device__ __forceinline__ void ph_l1_sel_ring(const Params& p) {
    constexpr int R = 8, SLOT_B = 16384, O_BKT = R * SLOT_B, O_TABL = O_BKT + 4096, O_CNT = O_TABL + 2176;
    LAS unsigned char* lds = (LAS unsigned char*)g_lds;
    LAS unsigned char* bkt = lds + O_BKT; LAS float* tabl = (LAS float*)(lds + O_TABL);
    LAS unsigned* cnt = (LAS unsigned*)(lds + O_CNT);
    const bf16_t* Qn = (const bf16_t*)(p.ws + OFF_QN);
    const bf16_t* KV = (const bf16_t*)(p.ws + SM_KV);
    const bf16_t *KS = KV + 2 * (KVSZ / 2), *VS = KV + 3 * (KVSZ / 2);
    const float* gate = (const float*)(p.ws + SM_GATE); const float* tab = p.in[I_RELB];
    const unsigned long long* selm = (const unsigned long long*)(p.ws + SM_IDX);
    const bf16_t* acc_o = (const bf16_t*)(p.ws + OFF_BIG); bf16_t* nsa_o = (bf16_t*)(p.ws + OFF_BIG + (size_t)T_ * 4096);
    const int tid = TIDX, lane = tid & 63, w = __builtin_amdgcn_readfirstlane(tid >> 6), hd = lane & 15, kg = lane >> 4;
    const float negB2 = ((const float*)(p.ws + OFF_BOUND))[2];
    for (int i = tid; i < 1024; i += 512) ((LAS unsigned*)bkt)[i] = ((const unsigned*)(p.ws + OFF_BKT))[i];
    for (int i = tid; i < 512; i += 512) tabl[i] = tab[i] * LOG2E_;
    if (tid < 16) tabl[512 + tid] = -1.0e30f;
    __syncthreads();
    if (tid >= 4033 - 3584 && tid < 512) bkt[3584 + tid] = (unsigned char)32;
    for (int uk = 0;; ++uk) {
        constexpr int NU = S_ / SEL_UQ;
        int bg, qt;
        if (gridDim.x == 256 && NU == 64 && B_ * 2 == 8) { if (uk >= 2) break; const int j = blockIdx.x >> 3; bg = blockIdx.x & 7; qt = uk ? NU - 1 - j : j; }
        else { const int unit = blockIdx.x + uk * gridDim.x; if (unit >= B_ * 2 * NU) break; bg = unit / NU; qt = unit % NU; }
        const int q0 = qt * SEL_UQ, b = bg >> 1, g = bg & 1;
        unsigned long long U = 0ull;
        for (int j = 0; j < SEL_UQ; ++j) U |= __hip_atomic_load(selm + (size_t)bg * S_ + q0 + j, __ATOMIC_RELAXED, __HIP_MEMORY_SCOPE_AGENT);
        unsigned long long mk4[SEL_NQW];
#pragma unroll
        for (int j = 0; j < SEL_NQW; ++j) { const unsigned long long v = __hip_atomic_load(selm + (size_t)bg * S_ + q0 + SEL_NQW * w + j, __ATOMIC_RELAXED, __HIP_MEMORY_SCOPE_AGENT);
            mk4[j] = ((unsigned long long)(unsigned)__builtin_amdgcn_readfirstlane((unsigned)(v >> 32)) << 32) | (unsigned long long)(unsigned)__builtin_amdgcn_readfirstlane((unsigned)v); }
        U = ((unsigned long long)(unsigned)__builtin_amdgcn_readfirstlane((unsigned)(U >> 32)) << 32) | (unsigned long long)(unsigned)__builtin_amdgcn_readfirstlane((unsigned)U);
        unsigned long long mkw = 0ull;
#pragma unroll
        for (int j = 0; j < SEL_NQW; ++j) mkw |= mk4[j];
        bf16x8_t qf[SEL_NPP][2];
#pragma unroll
        for (int pp = 0; pp < SEL_NPP; ++pp)
#pragma unroll
            for (int ks = 0; ks < 2; ++ks)
                qf[pp][ks] = *(const bf16x8_t*)(Qn + ((size_t)(b * 16 + g * 8 + (hd & 7)) * S_ + q0 + SEL_NQW * w + 2 * pp + (hd >> 3)) * 64 + 32 * ks + 8 * kg);
        f32x4_t oacc[SEL_NPP][4]; float lsum[SEL_NPP];
#pragma unroll
        for (int pp = 0; pp < SEL_NPP; ++pp) { lsum[pp] = 0.f;
#pragma unroll
            for (int dt = 0; dt < 4; ++dt) oacc[pp][dt] = (f32x4_t){0.f, 0.f, 0.f, 0.f}; }
        const bf16_t* Kg = KS + (size_t)bg * S_ * 64;
        const bf16_t* Vg = VS + (size_t)bg * 64 * S_;
        const int lrow = 8 * w + (lane >> 3), lch = (lane & 7) ^ (lane >> 3);
        const bf16_t* kl = Kg + (size_t)lrow * 64 + lch * 8;
        const bf16_t* vl = Vg + (size_t)lrow * S_ + lch * 8;
#pragma unroll
        for (int pp = 0; pp < SEL_NPP; ++pp) asm volatile("" : "+v"(qf[pp][0]), "+v"(qf[pp][1]));
        asm volatile("s_waitcnt vmcnt(0)" ::: "memory");
        __syncthreads();
        if (lane == 0) { cnt[w] = 0u; cnt[8 + w] = 0u; }
        __syncthreads();
        const float bfar = tabl[31 * 16 + g * 8 + (hd & 7)];
        const int NB = __builtin_popcountll(U);
        int n_load = 0, n_pub = 0;
        unsigned long long remL = U, remC = U;
#define RING_ISSUE() do { const unsigned mp_ = ring_min8(cnt); \
            while (n_load < NB && n_load < (int)mp_ + R) { const int ml_ = __builtin_ctzll(remL); remL &= remL - 1; const int so_ = (n_load & (R - 1)) * SLOT_B + w * 1024; \
                __builtin_amdgcn_global_load_lds((const unsigned*)(kl + (size_t)ml_ * 4096), (LAS unsigned*)(lds + so_), 16, 0, 0); \
                __builtin_amdgcn_global_load_lds((const unsigned*)(vl + (size_t)ml_ * 64), (LAS unsigned*)(lds + so_ + 8192), 16, 0, 0); ++n_load; } } while (0)
#define RING_PUBLISH() do { asm volatile("s_waitcnt vmcnt(0)" ::: "memory"); if (lane == 0) *(volatile LAS unsigned*)(cnt + 8 + w) = (unsigned)n_load; n_pub = n_load; } while (0)
        int fmin = 0;
        for (int n = 0; n < NB; ++n) {
            const int m = __builtin_ctzll(remC); remC &= remC - 1;
            if (n_pub < n_load) RING_PUBLISH();
            if (n_load < NB) RING_ISSUE();
            if ((mkw >> m) & 1ull) {
                while (fmin <= n) {
                    fmin = (int)ring_min8(cnt + 8);
                    if (fmin > n) break;
                    if (n_pub < n_load) RING_PUBLISH(); else __builtin_amdgcn_s_sleep(1);
                    if (n_load < NB) RING_ISSUE();
                }
                asm volatile("" ::: "memory");
                sel_block_sw(lds, (n & (R - 1)) * SLOT_B, m, mk4, qf, oacc, lsum, negB2, q0, w, g, hd, kg, bkt, tabl, bfar);
                asm volatile("s_waitcnt lgkmcnt(0)" ::: "memory");
            }
            if (lane == 0) *(volatile LAS unsigned*)(cnt + w) = (unsigned)(n + 1);
        }
        while (n_load < NB || n_pub < n_load) {
            if (n_pub < n_load) RING_PUBLISH(); else __builtin_amdgcn_s_sleep(1);
            if (n_load < NB) RING_ISSUE();
        }
#undef RING_ISSUE
#undef RING_PUBLISH
        {
            typedef unsigned u32x2s __attribute__((ext_vector_type(2)));
#pragma unroll
            for (int pp = 0; pp < SEL_NPP; ++pp) { float l = lsum[pp]; l += __shfl_xor(l, 16); l += __shfl_xor(l, 32);
                const size_t t = (size_t)b * S_ + q0 + SEL_NQW * w + 2 * pp + (hd >> 3); const int h = g * 8 + (hd & 7);
                const float sc = gate[t * 48 + h * 3 + 1] / l;
                u32x2s prev[4];
#pragma unroll
                for (int dt = 0; dt < 4; ++dt) { const unsigned long long pv_ = __hip_atomic_load((const unsigned long long*)(acc_o + t * 1024 + h * 64 + 16 * dt + 4 * kg), __ATOMIC_RELAXED, __HIP_MEMORY_SCOPE_AGENT); prev[dt] = (u32x2s){(unsigned)pv_, (unsigned)(pv_ >> 32)}; }
#pragma unroll
                for (int dt = 0; dt < 4; ++dt) { const f32x4_t a = oacc[pp][dt] * sc;
                    const float v0 = u2f(prev[dt].x << 16) + a[0], v1 = u2f(prev[dt].x & 0xffff0000u) + a[1], v2 = u2f(prev[dt].y << 16) + a[2], v3 = u2f(prev[dt].y & 0xffff0000u) + a[3];
                    *(u32x2s*)(nsa_o + t * 1024 + h * 64 + 16 * dt + 4 * kg) = (u32x2s){(unsigned)f2bf(v0) | ((unsigned)f2bf(v1) << 16), (unsigned)f2bf(v2) | ((unsigned)f2bf(v3) << 16)}; }
                asm volatile("" ::: "memory");
            }
        }
    }
}
#endif

#ifndef CPU_EMU
__device__ __forceinline__ void win_tile(LAS unsigned char* lds, int cur, int kt, const bf16x8_t (&qf)[4], f32x16& o0, f32x16& o1, float& l, float negB2, int qg, int r, int hh, const LAS float* mylut) {
    constexpr int ROWB = 144, TILE_B = 64 * ROWB;
            {
    f32x16 s0, s1;
#pragma unroll
    for (int i = 0; i < 16; ++i) { s0[i] = negB2; s1[i] = negB2; }
#pragma unroll
    for (int ks = 0; ks < 4; ++ks) {
        const bf16x8_t k0 = *(const LAS bf16x8_t*)(lds + cur + r * ROWB + (16 * ks + 8 * hh) * 2);
        const bf16x8_t k1 = *(const LAS bf16x8_t*)(lds + cur + (32 + r) * ROWB + (16 * ks + 8 * hh) * 2);
        s0 = __builtin_amdgcn_mfma_f32_32x32x16_bf16(k0, qf[ks], s0, 0, 0, 0);
        s1 = __builtin_amdgcn_mfma_f32_32x32x16_bf16(k1, qf[ks], s1, 0, 0, 0);
    }
    float ls = 0.f;
    int hq = hh, qq = qg; asm volatile("" : "+v"(hq), "+v"(qq));
#pragma unroll
    for (int i = 0; i < 16; ++i) {
        const int d0 = qq - (64 * kt + crow(i, hq));
        const float p0 = __builtin_amdgcn_exp2f(s0[i] + mylut[d0]), p1 = __builtin_amdgcn_exp2f(s1[i] + mylut[d0 - 32]);
        s0[i] = p0; s1[i] = p1; ls += p0 + p1;
    }
    l += ls;
    const bf16x8_t pa = pack8(s0, 0), pb = pack8(s0, 8), pc = pack8(s1, 0), pd = pack8(s1, 8);
    const LAS unsigned char* vb = lds + cur + TILE_B + r * ROWB + 8 * hh * 2;
#define PV_STEP(PF, SP) do { const bf16x8_t v0 = *(const LAS bf16x8_t*)(vb + (SP) * 32); const bf16x8_t v1 = *(const LAS bf16x8_t*)(vb + 32 * ROWB + (SP) * 32); \
        o0 = __builtin_amdgcn_mfma_f32_32x32x16_bf16(PF, v0, o0, 0, 0, 0); o1 = __builtin_amdgcn_mfma_f32_32x32x16_bf16(PF, v1, o1, 0, 0, 0); } while (0)
    PV_STEP(pa, 0); PV_STEP(pb, 1); PV_STEP(pc, 2); PV_STEP(pd, 3);
#undef PV_STEP
}
}

__device__ __forceinline__ void ph_l1_win_mfma(const Params& p) {
    constexpr int ROWB = 144, TILE_B = 64 * ROWB, BUF_B = 2 * TILE_B;
    LAS unsigned char* lds = (LAS unsigned char*)g_lds;
    constexpr int LW = 704, L0 = 96;
    LAS float* lut = (LAS float*)(lds + 2 * BUF_B);
    LAS float* lsum = (LAS float*)(lds + 2 * BUF_B + 16 * LW * 4);
    const bf16_t* Qn = (const bf16_t*)(p.ws + OFF_QN);
    const bf16_t* KV = (const bf16_t*)(p.ws + SM_KV);
    const bf16_t *KW = KV + 4 * (KVSZ / 2), *VW = KV + 5 * (KVSZ / 2);
    const float* gate = (const float*)(p.ws + SM_GATE); const float* tab = p.in[I_RELB];
    bf16_t* acc_o = (bf16_t*)(p.ws + OFF_BIG);
    const int tid = TIDX, lane = tid & 63, w = __builtin_amdgcn_readfirstlane(tid >> 6), r = lane & 31, hh = lane >> 5;
    const float negB2 = ((const float*)(p.ws + OFF_BOUND))[3];
    for (int i = tid; i < 16 * 512; i += 512) lut[(i >> 9) * LW + L0 + (i & 511)] = tab[t5_bucket(i & 511) * 16 + (i >> 9)] * LOG2E_;
    for (int i = tid; i < 16 * (LW - 512); i += 512) { const int hrow = i / (LW - 512), e = i % (LW - 512); lut[hrow * LW + (e < L0 ? e : 512 + e)] = -1.0e30f; }
    __syncthreads();
    for (int uk = 0;; ++uk) {
        int bg, qt; if (!nsa_unit(uk, bg, qt)) break;
        const int q0 = qt * 32, b = bg >> 1, g = bg & 1, h = g * 8 + w;
        const int qg = q0 + r;
        const int kt_lo = (q0 - 511 > 0 ? q0 - 511 : 0) >> 6, kt_hi = (q0 + 31) >> 6;
        const bf16_t* Kg = KW + (size_t)bg * S_ * 64;
        const bf16_t* Vg = VW + (size_t)bg * 64 * S_;
        bf16x8_t qf[4];
        { const bf16_t* Qp = Qn + ((size_t)(b * 16 + h) * S_ + qg) * 64;
#pragma unroll
          for (int ks = 0; ks < 4; ++ks) qf[ks] = *(const bf16x8_t*)(Qp + 16 * ks + 8 * hh); }
        f32x16 o0, o1;
#pragma unroll
        for (int i = 0; i < 16; ++i) { o0[i] = 0.f; o1[i] = 0.f; }
        float l = 0.f;
        const int srow = tid >> 3, sch = tid & 7, kdst = srow * ROWB + sch * 16, vdst = TILE_B + kdst;
        u32x4_t ak, av, bk, bv, ck, cv_;
        const LAS float* mylut = lut + h * LW + L0;
        const int NT = kt_hi - kt_lo + 1;
#define WIN_LOAD(T, RK, RV) do { GLD16(RK, Kg + (size_t)((kt_lo + (T)) * 64 + srow) * 64 + sch * 8); GLD16(RV, Vg + (size_t)srow * S_ + (kt_lo + (T)) * 64 + sch * 8); } while (0)
#define WIN_WAIT(N, RK, RV) asm volatile("s_waitcnt vmcnt(" #N ")" : "+v"(RK), "+v"(RV) :: "memory")
#define WIN_STEP(WK, WV, IK, IV) { if (t + 3 < NT) WIN_LOAD(t + 3, IK, IV); \
            win_tile(lds, cur, kt_lo + t, qf, o0, o1, l, negB2, qg, r, hh, mylut); \
            if (t + 1 < NT) { if (t + 3 < NT) WIN_WAIT(4, WK, WV); else if (t + 2 < NT) WIN_WAIT(2, WK, WV); else WIN_WAIT(0, WK, WV); *(LAS u32x4_t*)(lds + nxt + kdst) = WK; *(LAS u32x4_t*)(lds + nxt + vdst) = WV; } \
            __syncthreads(); if (++t >= NT) break; cur = nxt; nxt = BUF_B - cur; }
        asm volatile("" : "+v"(qf[0]), "+v"(qf[1]), "+v"(qf[2]), "+v"(qf[3]));
        asm volatile("s_waitcnt vmcnt(0)" ::: "memory");
        WIN_LOAD(0, ak, av); WIN_WAIT(0, ak, av);
        *(LAS u32x4_t*)(lds + kdst) = ak; *(LAS u32x4_t*)(lds + vdst) = av;
        if (NT > 1) WIN_LOAD(1, ak, av);
        if (NT > 2) WIN_LOAD(2, bk, bv);
        __syncthreads();
        int t = 0, cur = 0, nxt = BUF_B;
        for (;;) {
            WIN_STEP(ak, av, ck, cv_)
            WIN_STEP(bk, bv, ak, av)
            WIN_STEP(ck, cv_, bk, bv)
        }
#undef WIN_STEP
#undef WIN_LOAD
#undef WIN_WAIT
        l += __shfl_xor(l, 32);
        if (hh == 0) lsum[w * 32 + r] = l;
        __builtin_amdgcn_s_waitcnt(0xc07f);
        __builtin_amdgcn_wave_barrier();
        {
            float gsc[16];
#pragma unroll
            for (int i = 0; i < 16; ++i) { const int qr = crow(i, hh); gsc[i] = gate[((size_t)b * S_ + q0 + qr) * 48 + h * 3 + 2] / lsum[w * 32 + qr]; }
#pragma unroll
            for (int i = 0; i < 16; ++i) { const size_t o = ((size_t)b * S_ + q0 + crow(i, hh)) * 1024 + h * 64 + r; acc_o[o] = f2bf(o0[i] * gsc[i]); acc_o[o + 32] = f2bf(o1[i] * gsc[i]); }
        }
    }
}
#endif

struct EStoreF32 { float* out; int ldc; int ncols;
    MEMFN void operator()(int row, int col, f32x4 v) const { if (col < ncols) *(f32x4*)(out + (size_t)row * ldc + col) = v; } };
struct EResAddF32 { const float* res; float* out; int ldc;
    MEMFN void operator()(int row, int col, f32x4 v) const { const f32x4 r = *(const f32x4*)(res + (size_t)row * ldc + col); *(f32x4*)(out + (size_t)row * ldc + col) = r + v; } };
struct EStoreBf16 { bf16_t* out; int ldc;
    MEMFN void operator()(int row, int col, f32x4 v) const { typedef unsigned u32x2s_ __attribute__((ext_vector_type(2)));
        *(u32x2s_*)(out + (size_t)row * ldc + col) = (u32x2s_){(unsigned)f2bf(v[0]) | ((unsigned)f2bf(v[1]) << 16), (unsigned)f2bf(v[2]) | ((unsigned)f2bf(v[3]) << 16)}; } };
struct ERelu2Bf16 { bf16_t* out; int ldc;
    MEMFN void operator()(int row, int col, f32x4 v) const { bf16_t* d = out + (size_t)row * ldc + col;
        for (int j = 0; j < 4; ++j) { const float r = v[j] > 0.f ? v[j] : 0.f; d[j] = f2bf(r * r); } } };
struct EGeluBiasBf16 { bf16_t* out; int ldc; const float* bias;
    MEMFN void operator()(int row, int col, f32x4 v) const { bf16_t* d = out + (size_t)row * ldc + col;
        for (int j = 0; j < 4; ++j) d[j] = f2bf(gelu_tanh(v[j] + bias[col + j])); } };

#ifdef CPU_EMU
template <class F> static void gemm_emu(const bf16_t* A, int lda, const bf16_t* Bt, int M, int N, int K, const F& f) {
    if (GTID != 0) return;
#pragma omp parallel for
    for (int r = 0; r < M; ++r) {
        static thread_local float* arow = nullptr; if (!arow) arow = new float[8192];
        for (int k = 0; k < K; ++k) arow[k] = bf2f(A[(size_t)r * lda + k]);
        for (int c = 0; c < N; c += 4) { f32x4 acc = {0.f, 0.f, 0.f, 0.f};
            for (int j = 0; j < 4; ++j) { const bf16_t* brow = Bt + (size_t)(c + j) * K; float s = 0.f; for (int k = 0; k < K; ++k) s += arow[k] * bf2f(brow[k]); acc[j] = s; }
            f(r, c, acc); }
    }
}
#define GEMM(A, lda, Bt, M, N, K, f) gemm_emu(A, lda, Bt, M, N, K, f)
#else
namespace pg8 {
#define PG8_LAS __attribute__((address_space(3)))
typedef short bf16x8 __attribute__((ext_vector_type(8)));
constexpr int BM = 256, BK = 64, HALF = 128, HTB = HALF * BK * 2, STAGE_BYTES = 8 * HTB, NXCD = 8, WGM = 8;
__host__ __device__ __forceinline__ int lds_byte(int r, int c) { const int st = (r >> 4) * 2 + (c >> 5), rr = r & 15, cc = c & 31, ob = rr * 64 + cc * 2; return st * 1024 + (ob ^ (((ob >> 9) & 1) << 5)); }
__host__ __device__ __forceinline__ void stage_rc(int b, int& R, int& C) { const int st = b / 1024, sb = b % 1024, swz = sb ^ (((sb >> 9) & 1) << 5); R = (st >> 1) * 16 + swz / 64; C = (st & 1) * 32 + (swz % 64) / 2; }
struct Unit { int pm, pn; };
struct Gemm { const bf16_t* A; const bf16_t* Bt; int M, N, K, lda, ldb; };
struct StaticOrder {
    int nM, nN, nwg, G, c;
    __host__ __device__ void init(int M, int N, int G_, int c_) { nM = M / BM; nN = N / BM; nwg = nM * nN; G = G_; c = c_; }
    __host__ __device__ bool next(int i, Unit& u) const {
        const long L = (long)i * G + c; if (L >= nwg) return false;
        int wgid = (int)L; { const int q = nwg / NXCD, r = nwg % NXCD, xcd = wgid % NXCD, off = wgid / NXCD; wgid = (xcd < r ? xcd * (q + 1) : r * (q + 1) + (xcd - r) * q) + off; }
        const int nig = WGM * nN, gid = wgid / nig, fm = gid * WGM, gsz = (nM - fm) < WGM ? (nM - fm) : WGM;
        u.pm = fm + ((wgid % nig) % gsz); u.pn = (wgid % nig) / gsz; return true;
    }
};
template <class F> struct EpiElem {
    F f;
    __device__ __forceinline__ void operator()(const f32x4 (&acc)[2][2][4][2], const Unit& u, int wr, int wc, int fr, int fq) const {
        asm volatile("" : "+v"(fr), "+v"(fq));
#pragma unroll
        for (int ai = 0; ai < 2; ++ai)
#pragma unroll
            for (int m = 0; m < 4; ++m) { const int row = u.pm * BM + ai * HALF + wr * 64 + m * 16 + fr;
#pragma unroll
                for (int bj = 0; bj < 2; ++bj)
#pragma unroll
                    for (int n = 0; n < 2; ++n) f(row, u.pn * BM + bj * HALF + wc * 32 + n * 16 + 4 * fq, acc[ai][bj][m][n]); }
    }
};

__device__ __forceinline__ void row_rstd8(const float* ssq, int row0, int fq, float (&rstd)[2][4]) {
    f32x4 part[2][4];
#pragma unroll
    for (int ai = 0; ai < 2; ++ai)
#pragma unroll
        for (int m = 0; m < 4; ++m) part[ai][m] = *(const f32x4*)(ssq + (size_t)(row0 + ai * HALF + m * 16) * 16 + 4 * fq);
#pragma unroll
    for (int ai = 0; ai < 2; ++ai)
#pragma unroll
        for (int m = 0; m < 4; ++m) { const f32x4 a = part[ai][m]; float t = (a[0] + a[1]) + (a[2] + a[3]); t += __shfl_xor(t, 16); t += __shfl_xor(t, 32);
            rstd[ai][m] = 1.0f / sqrtf(t * (1.0f / 1024.0f) + EPS_); }
}
template <class F> struct EpiRowScale {
    F f; const float* ssq;
    __device__ __forceinline__ void operator()(const f32x4 (&acc)[2][2][4][2], const Unit& u, int wr, int wc, int fr, int fq) const {
        asm volatile("" : "+v"(fr), "+v"(fq));
        float rs8[2][4]; row_rstd8(ssq, u.pm * BM + wr * 64 + fr, fq, rs8);
#pragma unroll
        for (int ai = 0; ai < 2; ++ai)
#pragma unroll
            for (int m = 0; m < 4; ++m) { const int row = u.pm * BM + ai * HALF + wr * 64 + m * 16 + fr;
                const float rstd = rs8[ai][m];
#pragma unroll
                for (int bj = 0; bj < 2; ++bj)
#pragma unroll
                    for (int n = 0; n < 2; ++n) f(row, u.pn * BM + bj * HALF + wc * 32 + n * 16 + 4 * fq, acc[ai][bj][m][n] * rstd); }
    }
};
template <bool RES_F32, bool OUT_F32> struct EpiResNorm {
    const float* resf; const bf16_t* resb; float* outf; bf16_t* xb; float* ssq;
    static constexpr int GM = RES_F32 ? 2 : 4, NG = 8 / GM;
    struct Piece { f32x4 f0, f1; u32x4e b; };
    __device__ __forceinline__ void load_group(int gi, Piece (&P)[GM][2], const Unit& u, int wr, int wc, int fr, int fq) const {
#pragma unroll
        for (int mi = 0; mi < GM; ++mi) { const int am = gi * GM + mi, ai = am >> 2, m = am & 3; const int row = u.pm * BM + ai * HALF + wr * 64 + m * 16 + fr;
#pragma unroll
            for (int bj = 0; bj < 2; ++bj) { const size_t o = (size_t)row * 1024 + u.pn * BM + bj * HALF + wc * 32 + 8 * fq;
                if (RES_F32) { P[mi][bj].f0 = *(const f32x4*)(resf + o); P[mi][bj].f1 = *(const f32x4*)(resf + o + 4); } else P[mi][bj].b = *(const u32x4e*)(resb + o); } }
    }
    __device__ __forceinline__ void operator()(const f32x4 (&acc)[2][2][4][2], const Unit& u, int wr, int wc, int fr, int fq) const {
        asm volatile("" : "+v"(fr), "+v"(fq));
        Piece cur[GM][2], nxt[GM][2];
        load_group(0, cur, u, wr, wc, fr, fq);
#pragma unroll
        for (int gi = 0; gi < NG; ++gi) {
            if (gi + 1 < NG) load_group(gi + 1, nxt, u, wr, wc, fr, fq);
#pragma unroll
            for (int mi = 0; mi < GM; ++mi) { const int am = gi * GM + mi, ai = am >> 2, m = am & 3; const int row = u.pm * BM + ai * HALF + wr * 64 + m * 16 + fr; float ss = 0.f;
#pragma unroll
                for (int bj = 0; bj < 2; ++bj) { const size_t o = (size_t)row * 1024 + u.pn * BM + bj * HALF + wc * 32 + 8 * fq;
                    f32x4 r0, r1;
                    if (RES_F32) { r0 = cur[mi][bj].f0; r1 = cur[mi][bj].f1; }
                    else { const u32x4e rb = cur[mi][bj].b; r0 = (f32x4){u2f(rb.x << 16), u2f(rb.x & 0xffff0000u), u2f(rb.y << 16), u2f(rb.y & 0xffff0000u)};
                                                           r1 = (f32x4){u2f(rb.z << 16), u2f(rb.z & 0xffff0000u), u2f(rb.w << 16), u2f(rb.w & 0xffff0000u)}; }
                    const f32x4 v0 = r0 + acc[ai][bj][m][0], v1 = r1 + acc[ai][bj][m][1];
                    if (OUT_F32) { *(f32x4*)(outf + o) = v0; *(f32x4*)(outf + o + 4) = v1; }
                    else { const unsigned w0 = (unsigned)f2bf(v0[0]) | ((unsigned)f2bf(v0[1]) << 16), w1 = (unsigned)f2bf(v0[2]) | ((unsigned)f2bf(v0[3]) << 16),
                                          w2 = (unsigned)f2bf(v1[0]) | ((unsigned)f2bf(v1[1]) << 16), w3 = (unsigned)f2bf(v1[2]) | ((unsigned)f2bf(v1[3]) << 16);
                        *(u32x4e*)(xb + o) = (u32x4e){w0, w1, w2, w3};
                        const float q0 = u2f(w0 << 16), q1 = u2f(w0 & 0xffff0000u), q2 = u2f(w1 << 16), q3 = u2f(w1 & 0xffff0000u), q4 = u2f(w2 << 16), q5 = u2f(w2 & 0xffff0000u), q6 = u2f(w3 << 16), q7 = u2f(w3 & 0xffff0000u);
                        ss += ((q0 * q0 + q1 * q1) + (q2 * q2 + q3 * q3)) + ((q4 * q4 + q5 * q5) + (q6 * q6 + q7 * q7)); } }
                if (!OUT_F32) { ss += __shfl_xor(ss, 16); ss += __shfl_xor(ss, 32);
                    if (fq == 0) ssq[(size_t)row * 16 + u.pn * 4 + wc] = ss; } }
            asm volatile("" ::: "memory");
#pragma unroll
            for (int mi = 0; mi < GM; ++mi)
#pragma unroll
                for (int bj = 0; bj < 2; ++bj) cur[mi][bj] = nxt[mi][bj];
        }
    }
};
template <bool QPART> struct EpiNsaIn {
    const float* ssq; const float* gq; const float* gk; bf16_t* Qn; bf16_t* KV; float* gate;
    __device__ __forceinline__ void operator()(const f32x4 (&acc)[2][2][4][2], const Unit& u, int wr, int wc, int fr, int fq) const {
        asm volatile("" : "+v"(fr), "+v"(fq));
        const int unit = u.pn * 4 + wc + (QPART ? 0 : 16);
        if (unit > 28) return;
        const bool is_q = QPART; const int x = (unit - 16) >> 1, gg = (unit - 16) & 1;
        const bool normed = is_q || x == 2 || x == 4;
        const float* g = is_q ? gq : (x == 2 ? gk + 64 : gk + 128);
        const float qs = is_q ? 0.125f * LOG2E_ : 1.0f;
        float rs8[2][4]; row_rstd8(ssq, u.pm * BM + wr * 64 + fr, fq, rs8);
        f32x4 gv[2][2];
#pragma unroll
        for (int bj = 0; bj < 2; ++bj)
#pragma unroll
            for (int n = 0; n < 2; ++n) gv[bj][n] = normed ? *(const f32x4*)(g + 32 * bj + 16 * n + 4 * fq) : (f32x4){1.f, 1.f, 1.f, 1.f};
#pragma unroll
        for (int ai = 0; ai < 2; ++ai)
#pragma unroll
            for (int m = 0; m < 4; ++m) { const int t = u.pm * BM + ai * HALF + wr * 64 + m * 16 + fr; const int b = t / S_, s = t - b * S_;
                const float rstd = rs8[ai][m];
                float ss = 0.f;
#pragma unroll
                for (int bj = 0; bj < 2; ++bj)
#pragma unroll
                    for (int n = 0; n < 2; ++n) { const f32x4 w = acc[ai][bj][m][n]; ss += (w[0] * w[0] + w[1] * w[1]) + (w[2] * w[2] + w[3] * w[3]); }
                float fsc = rstd;
                if (normed) { ss += __shfl_xor(ss, 16); ss += __shfl_xor(ss, 32); fsc = rstd * qs / sqrtf(ss * rstd * rstd * (1.0f / 64.0f) + EPS_); }
#define NSA_V(bj, n) (normed ? acc[ai][bj][m][n] * gv[bj][n] * fsc : acc[ai][bj][m][n] * fsc)
                if (unit == 28) {
#pragma unroll
                    for (int bj = 0; bj < 2; ++bj)
#pragma unroll
                        for (int n = 0; n < 2; ++n)
#pragma unroll
                            for (int j = 0; j < 4; ++j) { const int c = 32 * bj + 16 * n + 4 * fq + j; if (c < 48) gate[(size_t)t * 48 + c] = 1.0f / (1.0f + expf(-(NSA_V(bj, n))[j])); }
                } else if (!is_q && (x == 3 || x == 5)) {
                    PG8_LAS unsigned char* scr = (PG8_LAS unsigned char*)g_lds + 131072 + (wr * 4 + wc) * 2048;
#pragma unroll
                    for (int bj = 0; bj < 2; ++bj)
#pragma unroll
                        for (int n = 0; n < 2; ++n)
#pragma unroll
                            for (int j = 0; j < 4; ++j) *(PG8_LAS bf16_t*)(scr + (32 * bj + 16 * n + 4 * fq + j) * 32 + fr * 2) = f2bf((NSA_V(bj, n))[j]);
                    asm volatile("s_waitcnt lgkmcnt(0)" ::: "memory");
                    const int t0 = t - fr, s0 = t0 - b * S_; const int lane_ = fq * 16 + fr;
#pragma unroll
                    for (int k = 0; k < 4; ++k) { const int piece = lane_ + 64 * k, d = piece >> 2, run = piece & 3;
                        typedef unsigned u32x2_ __attribute__((ext_vector_type(2)));
                        const u32x2_ vv = *(const PG8_LAS u32x2_*)(scr + d * 32 + run * 8);
                        const int pos = (x == 3) ? ((s0 & ~31) | (8 * run + 4 * ((s0 >> 4) & 1))) : ((s0 & ~15) | (8 * (run & 1) + 4 * (run >> 1)));
                        *(u32x2_*)(KV + (size_t)x * (KVSZ / 2) + ((size_t)(b * 2 + gg) * 64 + d) * S_ + pos) = vv; }
                    asm volatile("s_waitcnt lgkmcnt(0)" ::: "memory");
                } else {
                    bf16_t* base = is_q ? Qn + ((size_t)(b * 16 + unit) * S_ + s) * 64 : KV + (size_t)x * (KVSZ / 2) + ((size_t)(b * 2 + gg) * S_ + s) * 64;
                    typedef unsigned u32x2_ __attribute__((ext_vector_type(2)));
#pragma unroll
                    for (int bj = 0; bj < 2; ++bj)
#pragma unroll
                        for (int n = 0; n < 2; ++n) { const f32x4 w = NSA_V(bj, n);
                            *(u32x2_*)(base + 32 * bj + 16 * n + 4 * fq) = (u32x2_){(unsigned)f2bf(w[0]) | ((unsigned)f2bf(w[1]) << 16), (unsigned)f2bf(w[2]) | ((unsigned)f2bf(w[3]) << 16)}; }
                }
                asm volatile("" ::: "memory");
            }
#undef NSA_V
    }
};

struct EpiGates {
    const bf16_t* xc; float* z0; const float *ba, *bx, *lam; int col0;
    __device__ __forceinline__ void operator()(const f32x4 (&acc)[2][2][4][2], const Unit& u, int wr, int wc, int fr, int fq) const {
        asm volatile("" : "+v"(fr), "+v"(fq));
        float sp[2][2][2], b_a[2][2][2], b_x[2][2][2];
#pragma unroll
        for (int bj = 0; bj < 2; ++bj)
#pragma unroll
            for (int n = 0; n < 2; ++n)
#pragma unroll
                for (int j = 0; j < 2; ++j) { const int c = (col0 + u.pn * BM + bj * HALF + wc * 32 + n * 16 + 4 * fq) / 2 + j;
                    sp[bj][n][j] = log1pf(expf(-lam[c])); b_a[bj][n][j] = ba[c]; b_x[bj][n][j] = bx[c]; }
#pragma unroll
        for (int ai = 0; ai < 2; ++ai) {
            unsigned xw8[4][2][2];
#pragma unroll
            for (int m = 0; m < 4; ++m)
#pragma unroll
                for (int bj = 0; bj < 2; ++bj)
#pragma unroll
                    for (int n = 0; n < 2; ++n) xw8[m][bj][n] = *(const unsigned*)(xc + (size_t)(u.pm * BM + ai * HALF + wr * 64 + m * 16 + fr) * 512 + (col0 + u.pn * BM + bj * HALF + wc * 32 + n * 16 + 4 * fq) / 2);
#pragma unroll
            for (int m = 0; m < 4; ++m) { const int t = u.pm * BM + ai * HALF + wr * 64 + m * 16 + fr; const bool first = (t % S_) == 0;
#pragma unroll
                for (int bj = 0; bj < 2; ++bj)
#pragma unroll
                    for (int n = 0; n < 2; ++n) { const int c0 = (col0 + u.pn * BM + bj * HALF + wc * 32 + n * 16 + 4 * fq) / 2;
                        const unsigned xw = xw8[m][bj][n]; const f32x4 v = acc[ai][bj][m][n];
                        float av[2], bv[2];
#pragma unroll
                        for (int j = 0; j < 2; ++j) { const float xv = u2f(j ? (xw & 0xffff0000u) : (xw << 16));
                            const float r = 1.0f / (1.0f + expf(-(v[2 * j] + b_a[bj][n][j]))), ig = 1.0f / (1.0f + expf(-(v[2 * j + 1] + b_x[bj][n][j])));
                            const float log_a = -8.0f * r * sp[bj][n][j];
                            av[j] = expf(log_a); const float mult = first ? 1.0f : sqrtf(-expm1f(2.0f * log_a)); bv[j] = mult * (ig * xv); }
                        typedef float f32x2_ __attribute__((ext_vector_type(2)));
                        *(f32x2_*)(z0 + (size_t)t * 1024 + c0) = (f32x2_){av[0], av[1]}; *(f32x2_*)(z0 + (size_t)t * 1024 + 512 + c0) = (f32x2_){bv[0], bv[1]}; }
                asm volatile("" ::: "memory");
            }
        }
    }
};

struct EpiMlaKV {
    unsigned char* ws; unsigned char* outb; const float* gk;
    __device__ __forceinline__ void operator()(const f32x4 (&acc)[2][2][4][2], const Unit& u, int wr, int wc, int fr, int fq) const {
        asm volatile("" : "+v"(fr), "+v"(fq));
        const float* kr = (const float*)(ws + SM_KROPE); const float* rope = (const float*)(ws + OFF_ROPE); bf16_t* K0 = (bf16_t*)(outb + DO_K0); bf16_t* V0 = (bf16_t*)(outb + DO_V0);
        const int unit = u.pn * 4 + wc, h = unit >> 1; const bool isv = unit & 1;
        typedef unsigned u32x2_ __attribute__((ext_vector_type(2)));
        if (isv) {
            const int wid8 = wr * 4 + wc; const int lane = fq * 16 + fr;
            PG8_LAS unsigned char* scr = (PG8_LAS unsigned char*)g_lds + 131072 + wid8 * 2048;
            const int pfr = 8 * ((fr >> 2) & 1) + 4 * ((fr >> 3) & 1) + (fr & 3);
#pragma unroll
            for (int ai = 0; ai < 2; ++ai)
#pragma unroll
                for (int m = 0; m < 4; ++m) { const int t0 = u.pm * BM + ai * HALF + wr * 64 + m * 16; const int b = t0 / S_, s0 = t0 - b * S_;
#pragma unroll
                    for (int bj = 0; bj < 2; ++bj)
#pragma unroll
                        for (int n = 0; n < 2; ++n)
#pragma unroll
                            for (int j = 0; j < 4; ++j) *(PG8_LAS bf16_t*)(scr + (32 * bj + 16 * n + 4 * fq + j) * 32 + pfr * 2) = f2bf(acc[ai][bj][m][n][j]);
                    asm volatile("s_waitcnt lgkmcnt(0)" ::: "memory");
#pragma unroll
                    for (int k = 0; k < 2; ++k) { const int piece = lane + 64 * k, d = piece >> 1, hf = piece & 1;
                        const u32x4e vv = *(const PG8_LAS u32x4e*)(scr + d * 32 + hf * 16);
                        *(u32x4e*)(V0 + ((size_t)(b * 8 + h) * 64 + d) * S_ + s0 + hf * 8) = vv; }
                    asm volatile("s_waitcnt lgkmcnt(0)" ::: "memory"); }
        } else {
#pragma unroll
            for (int ai = 0; ai < 2; ++ai)
#pragma unroll
                for (int m = 0; m < 4; ++m) { int fr_ = fr; asm volatile("" : "+v"(fr_));
                    const int t = u.pm * BM + ai * HALF + wr * 64 + m * 16 + fr_; const int b = t / S_, s = t - b * S_;
                    f32x4 k1 = *(const f32x4*)(kr + (size_t)t * 32 + 4 * fq), k2 = *(const f32x4*)(kr + (size_t)t * 32 + 16 + 4 * fq);
                    float ss = (k1[0] * k1[0] + k1[1] * k1[1]) + (k1[2] * k1[2] + k1[3] * k1[3]) + (k2[0] * k2[0] + k2[1] * k2[1]) + (k2[2] * k2[2] + k2[3] * k2[3]);
#pragma unroll
                    for (int bj = 0; bj < 2; ++bj)
#pragma unroll
                        for (int n = 0; n < 2; ++n) { const f32x4 w = acc[ai][bj][m][n]; ss += (w[0] * w[0] + w[1] * w[1]) + (w[2] * w[2] + w[3] * w[3]); }
                    ss += __shfl_xor(ss, 16); ss += __shfl_xor(ss, 32);
                    const float rstd = 1.0f / sqrtf(ss * (1.0f / 96.0f) + EPS_);
                    bf16_t* base = K0 + ((size_t)(b * 8 + h) * S_ + s) * 96;
#pragma unroll
                    for (int bj = 0; bj < 2; ++bj)
#pragma unroll
                        for (int n = 0; n < 2; ++n) { const int c = 32 * bj + 16 * n + 4 * fq; const f32x4 w = acc[ai][bj][m][n] * *(const f32x4*)(gk + c) * rstd;
                            *(u32x2_*)(base + c) = (u32x2_){(unsigned)f2bf(w[0]) | ((unsigned)f2bf(w[1]) << 16), (unsigned)f2bf(w[2]) | ((unsigned)f2bf(w[3]) << 16)};
                            asm volatile("" ::: "memory"); }
                    k1 = k1 * *(const f32x4*)(gk + 64 + 4 * fq) * rstd; k2 = k2 * *(const f32x4*)(gk + 80 + 4 * fq) * rstd;
                    { const f32x4 cs = *(const f32x4*)(rope + (size_t)s * 16 + 4 * fq), sn = *(const f32x4*)(rope + (size_t)(S_ + s) * 16 + 4 * fq);
                      const f32x4 o1 = k1 * cs - k2 * sn; k2 = k2 * cs + k1 * sn; k1 = o1; }
                    *(u32x2_*)(base + 64 + 4 * fq) = (u32x2_){(unsigned)f2bf(k1[0]) | ((unsigned)f2bf(k1[1]) << 16), (unsigned)f2bf(k1[2]) | ((unsigned)f2bf(k1[3]) << 16)};
                    *(u32x2_*)(base + 80 + 4 * fq) = (u32x2_){(unsigned)f2bf(k2[0]) | ((unsigned)f2bf(k2[1]) << 16), (unsigned)f2bf(k2[2]) | ((unsigned)f2bf(k2[3]) << 16)};
                    asm volatile("" ::: "memory"); }
        }
    }
};

struct EpiUpRelu2Perm {
    bf16_t* out; const float* ssq;
    __device__ __forceinline__ void operator()(const f32x4 (&acc)[2][2][4][2], const Unit& u, int wr, int wc, int fr, int fq) const {
        asm volatile("" : "+v"(fr), "+v"(fq));
        float rs8[2][4]; row_rstd8(ssq, u.pm * BM + wr * 64 + fr, fq, rs8);
#pragma unroll
        for (int ai = 0; ai < 2; ++ai)
#pragma unroll
            for (int m = 0; m < 4; ++m) { const int row = u.pm * BM + ai * HALF + wr * 64 + m * 16 + fr;
                const float rstd = rs8[ai][m];
#pragma unroll
                for (int bj = 0; bj < 2; ++bj) { f32x4 v0 = acc[ai][bj][m][0] * rstd, v1 = acc[ai][bj][m][1] * rstd;
#pragma unroll
                    for (int j = 0; j < 4; ++j) { const float r0 = v0[j] > 0.f ? v0[j] : 0.f, r1 = v1[j] > 0.f ? v1[j] : 0.f; v0[j] = r0 * r0; v1[j] = r1 * r1; }
                    *(u32x4e*)(out + (size_t)row * 4096 + u.pn * BM + bj * HALF + wc * 32 + 8 * fq) = (u32x4e){(unsigned)f2bf(v0[0]) | ((unsigned)f2bf(v0[1]) << 16), (unsigned)f2bf(v0[2]) | ((unsigned)f2bf(v0[3]) << 16),
                                                                                                               (unsigned)f2bf(v1[0]) | ((unsigned)f2bf(v1[1]) << 16), (unsigned)f2bf(v1[2]) | ((unsigned)f2bf(v1[3]) << 16)}; }
                asm volatile("" ::: "memory"); }
    }
};

struct EpiStoreBf16Perm {
    bf16_t* out; int ld;
    __device__ __forceinline__ void operator()(const f32x4 (&acc)[2][2][4][2], const Unit& u, int wr, int wc, int fr, int fq) const {
        asm volatile("" : "+v"(fr), "+v"(fq));
#pragma unroll
        for (int ai = 0; ai < 2; ++ai)
#pragma unroll
            for (int m = 0; m < 4; ++m) { const int row = u.pm * BM + ai * HALF + wr * 64 + m * 16 + fr;
#pragma unroll
                for (int bj = 0; bj < 2; ++bj) { const f32x4 v0 = acc[ai][bj][m][0], v1 = acc[ai][bj][m][1];
                    *(u32x4e*)(out + (size_t)row * ld + u.pn * BM + bj * HALF + wc * 32 + 8 * fq) = (u32x4e){(unsigned)f2bf(v0[0]) | ((unsigned)f2bf(v0[1]) << 16), (unsigned)f2bf(v0[2]) | ((unsigned)f2bf(v0[3]) << 16),
                                                                                                          (unsigned)f2bf(v1[0]) | ((unsigned)f2bf(v1[1]) << 16), (unsigned)f2bf(v1[2]) | ((unsigned)f2bf(v1[3]) << 16)}; }
                asm volatile("" ::: "memory"); }
    }
};

template <class Epi, bool ALIGN_EPI = true>
__device__ __forceinline__ void gemm_phase(PG8_LAS unsigned char* lds, const Gemm g, const StaticOrder& S, const Epi& E) {
    const int tid = TIDX, wid = __builtin_amdgcn_readfirstlane(tid >> 6), lane = tid & 63, wr = wid >> 2, wc = wid & 3, fr = lane & 15, fq = lane >> 4;
    int K_ = g.K; asm volatile("" : "+s"(K_));
    const int K = K_, nt = K / BK, lda = g.lda, ldb = g.ldb;
    unsigned voffA[2], voffB[2];
#pragma unroll
    for (int i = 0; i < 2; ++i) { int R, C; stage_rc(tid * 16 + i * 8192, R, C); voffA[i] = (unsigned)(R * lda + C) * 2u; voffB[i] = (unsigned)(R * ldb + C) * 2u; }
    const size_t kstep = (size_t)(BK * 2);
    const size_t hstepA = (size_t)HALF * lda * 2, hstepB = (size_t)HALF * ldb * 2;
    const size_t tstepA = 2 * hstepA, tstepB = 2 * hstepB;
    const unsigned ldsw = (unsigned)wid * 1024u;
    const int aoff = lds_byte(wr * 64 + fr, fq * 8), boff = lds_byte(wc * 32 + fr, fq * 8);
#define PG8_SA(b, h) (((b) * 2 + (h)) * HTB)
#define PG8_SB(b, h) ((4 + (b) * 2 + (h)) * HTB)
#define PG8_STAGE(bufoff, gbase, voff) do { _Pragma("unroll") for (int _i = 0; _i < 2; ++_i) \
        __builtin_amdgcn_global_load_lds((const unsigned*)((const char*)(gbase) + (voff)[_i]), (PG8_LAS unsigned*)(lds + (bufoff) + ldsw + _i * 8192), 16, 0, 0); } while (0)
#define PG8_LDA(dst, b, h) do { _Pragma("unroll") for (int m = 0; m < 4; ++m) _Pragma("unroll") for (int k = 0; k < 2; ++k) dst[m][k] = *(const PG8_LAS bf16x8*)(lds + PG8_SA(b, h) + aoff + m * 2048 + k * 1024); } while (0)
#define PG8_LDB(dst, b, h) do { _Pragma("unroll") for (int n = 0; n < 2; ++n) _Pragma("unroll") for (int k = 0; k < 2; ++k) dst[n][k] = *(const PG8_LAS bf16x8*)(lds + PG8_SB(b, h) + boff + n * 2048 + k * 1024); } while (0)
#define PG8_MMA(ai, bj, At, Bt) do { __builtin_amdgcn_s_setprio(1); _Pragma("unroll") for (int m = 0; m < 4; ++m) _Pragma("unroll") for (int n = 0; n < 2; ++n) _Pragma("unroll") for (int k = 0; k < 2; ++k) \
        acc[ai][bj][m][n] = __builtin_amdgcn_mfma_f32_16x16x32_bf16(Bt[n][k], At[m][k], acc[ai][bj][m][n], 0, 0, 0); __builtin_amdgcn_s_setprio(0); } while (0)
#define PG8_WAIT_V(n) asm volatile("s_waitcnt vmcnt(" #n ")" ::: "memory")
#define PG8_WAIT_L(n) asm volatile("s_waitcnt lgkmcnt(" #n ")" ::: "memory")
#define PG8_BAR __builtin_amdgcn_s_barrier()
#define PG8_SCHED __builtin_amdgcn_sched_barrier(0)
    Unit cur, nxt; int ui = 0;
    if (!S.next(0, cur)) return;
    f32x4 acc[2][2][4][2];
#pragma unroll
    for (int a = 0; a < 2; ++a)
#pragma unroll
        for (int b = 0; b < 2; ++b)
#pragma unroll
            for (int m = 0; m < 4; ++m)
#pragma unroll
                for (int n = 0; n < 2; ++n) acc[a][b][m][n] = (f32x4){0.f, 0.f, 0.f, 0.f};
    bf16x8 At[4][2], B0[2][2], B1[2][2];
    const char* cA = (const char*)g.A + (size_t)cur.pm * tstepA; const char* cB = (const char*)g.Bt + (size_t)cur.pn * tstepB;
    PG8_STAGE(PG8_SB(0, 0), cB, voffB); PG8_STAGE(PG8_SB(0, 1), cB + hstepB, voffB); PG8_STAGE(PG8_SA(0, 0), cA, voffA); PG8_STAGE(PG8_SA(0, 1), cA + hstepA, voffA);
    if (wr == 1) PG8_BAR;
    PG8_WAIT_V(2); PG8_BAR;
    PG8_STAGE(PG8_SB(1, 0), cB + kstep, voffB); PG8_STAGE(PG8_SA(1, 0), cA + kstep, voffA); PG8_STAGE(PG8_SB(1, 1), cB + hstepB + kstep, voffB);
    PG8_WAIT_V(6); PG8_BAR;
    for (;;) {
        const bool has_next = S.next(ui + 1, nxt);
        const char* nA = has_next ? (const char*)g.A + (size_t)nxt.pm * tstepA : cA; const char* nB = has_next ? (const char*)g.Bt + (size_t)nxt.pn * tstepB : cB;
        for (int t = 0; t < nt; t += 2) {
            const bool last = (t == nt - 2);
            const char* a1 = cA + (size_t)(t + 1) * kstep;
            const char* a2 = last ? nA : cA + (size_t)(t + 2) * kstep; const char* b2 = last ? nB : cB + (size_t)(t + 2) * kstep;
            const char* a3 = a2 + kstep; const char* b3 = b2 + kstep;
            PG8_LDB(B0, 0, 0); PG8_LDB(B1, 0, 1); PG8_SCHED; PG8_LDA(At, 0, 0); PG8_STAGE(PG8_SA(1, 1), a1 + hstepA, voffA);
            PG8_WAIT_V(8); PG8_WAIT_L(0); PG8_BAR; PG8_MMA(0, 0, At, B0); PG8_MMA(0, 1, At, B1); PG8_BAR; PG8_SCHED;
            PG8_LDA(At, 0, 1); PG8_STAGE(PG8_SB(0, 0), b2, voffB); PG8_STAGE(PG8_SB(0, 1), b2 + hstepB, voffB); PG8_STAGE(PG8_SA(0, 0), a2, voffA);
            PG8_WAIT_V(8); PG8_WAIT_L(0); PG8_BAR; PG8_MMA(1, 0, At, B0); PG8_MMA(1, 1, At, B1); PG8_BAR; PG8_SCHED;
            PG8_LDB(B0, 1, 0); PG8_LDB(B1, 1, 1); PG8_SCHED; PG8_LDA(At, 1, 0); PG8_STAGE(PG8_SA(0, 1), a2 + hstepA, voffA);
            PG8_WAIT_V(8); PG8_WAIT_L(0); PG8_BAR; PG8_MMA(0, 0, At, B0); PG8_MMA(0, 1, At, B1); PG8_BAR; PG8_SCHED;
            PG8_LDA(At, 1, 1); PG8_STAGE(PG8_SB(1, 0), b3, voffB); PG8_STAGE(PG8_SB(1, 1), b3 + hstepB, voffB); PG8_STAGE(PG8_SA(1, 0), a3, voffA);
            PG8_WAIT_V(8); PG8_WAIT_L(0); PG8_BAR; PG8_MMA(1, 0, At, B0); PG8_MMA(1, 1, At, B1); PG8_BAR; PG8_SCHED;
        }
        if constexpr (ALIGN_EPI) { if (wr == 0) PG8_BAR; }
        { const int ln_ = (int)__builtin_amdgcn_mbcnt_hi(~0u, __builtin_amdgcn_mbcnt_lo(~0u, 0u)); E(acc, cur, wr, wc, ln_ & 15, ln_ >> 4); }
        if (!has_next) break;
#pragma unroll
        for (int a = 0; a < 2; ++a)
#pragma unroll
            for (int b = 0; b < 2; ++b)
#pragma unroll
                for (int m = 0; m < 4; ++m)
#pragma unroll
                    for (int n = 0; n < 2; ++n) acc[a][b][m][n] = (f32x4){0.f, 0.f, 0.f, 0.f};
        cur = nxt; cA = nA; cB = nB; ++ui;
        if constexpr (ALIGN_EPI) { if (wr == 1) PG8_BAR; }
    }
    PG8_WAIT_V(0);
    if constexpr (!ALIGN_EPI) { if (wr == 0) PG8_BAR; }
    PG8_BAR;
#undef PG8_SA
#undef PG8_SB
#undef PG8_STAGE
#undef PG8_LDA
#undef PG8_LDB
#undef PG8_MMA
#undef PG8_WAIT_V
#undef PG8_WAIT_L
#undef PG8_BAR
#undef PG8_SCHED
}
}
template <class F> __device__ __forceinline__ void gemm_gpu(const bf16_t* A, int lda, const bf16_t* Bt, int M, int N, int K, const F& f, int block_shift = 0, int ldb = 0) {
    pg8::Gemm g{A, Bt, M, N, K, lda, ldb ? ldb : K}; pg8::StaticOrder S; S.init(M, N, (int)gridDim.x, (int)((blockIdx.x + gridDim.x - block_shift) % gridDim.x));
    pg8::EpiElem<F> E{f};
    pg8::gemm_phase<pg8::EpiElem<F>, true>((PG8_LAS unsigned char*)g_lds, g, S, E);
}
template <class E> __device__ __forceinline__ void gemm_gpu_epi(const bf16_t* A, int lda, const bf16_t* Bt, int M, int N, int K, const E& e, int block_shift = 0, int ldb = 0) {
    pg8::Gemm g{A, Bt, M, N, K, lda, ldb ? ldb : K}; pg8::StaticOrder S; S.init(M, N, (int)gridDim.x, (int)((blockIdx.x + gridDim.x - block_shift) % gridDim.x));
    pg8::gemm_phase<E, true>((PG8_LAS unsigned char*)g_lds, g, S, e);
}
#define GEMM(A, lda, Bt, M, N, K, f) gemm_gpu(A, lda, Bt, M, N, K, f)
#endif

#ifndef CPU_EMU
#define XB_TMO      128
#define XB_XCNT(j)  (256  + 64 * (j))
#define XB_XSUB(j)  (1280 + 64 * (j))
#define XB_XGEN(j)  (2304 + 64 * (j))
#define XB_TOP      3328
#define XB_TOPGEN   3392
#define XCD_BAR_WORDS 3456
#define XB_SPIN_CAP (1u << 18)
__device__ __forceinline__ unsigned xb_ld(unsigned* p)              { return __hip_atomic_load(p, __ATOMIC_RELAXED, __HIP_MEMORY_SCOPE_AGENT); }
__device__ __forceinline__ unsigned xb_add(unsigned* p, unsigned v) { return __hip_atomic_fetch_add(p, v, __ATOMIC_RELAXED, __HIP_MEMORY_SCOPE_AGENT); }
__device__ __forceinline__ unsigned xb_xcc_id() { return (unsigned)__builtin_amdgcn_s_getreg((3 << 11) | 20) & 0xFu; }
#define XB_SPIN(cond, bar) do { unsigned _sp = 0; while (cond) { __builtin_amdgcn_s_sleep(1); \
    if ((++_sp & 255u) == 0u) { if (xb_ld(&(bar)[XB_TMO])) break; if (_sp > XB_SPIN_CAP) { atomicAdd(&(bar)[XB_TMO], 1u); break; } } } } while (0)
struct XcdBarrier { unsigned* bar; unsigned x; volatile LAS unsigned* st; };
__device__ __forceinline__ XcdBarrier xcd_barrier_post(unsigned* bar, volatile LAS unsigned* st) {
    XcdBarrier b; b.bar = bar; b.x = xb_xcc_id(); b.st = st;
    return b;
}
__device__ __forceinline__ void xcd_barrier_census(const XcdBarrier& b) { if (TIDX == 0) (void)xb_add(&b.bar[XB_XCNT(b.x)], 1u); }
__device__ __forceinline__ void xcd_barrier_complete(unsigned* bar, unsigned x, unsigned& nloc, unsigned& nx) {
    const unsigned G = gridDim.x * gridDim.y * gridDim.z;
    unsigned sum, cnt, mine, sp = 0u;
    for (;;) {
        sum = 0u; cnt = 0u; mine = 0u;
#pragma unroll
        for (unsigned j = 0; j < 16; ++j) { const unsigned c = xb_ld(&bar[XB_XCNT(j)]); sum += c; cnt += (c > 0u) ? 1u : 0u; mine = (j == x) ? c : mine; }
        if (sum == G) break;
        __builtin_amdgcn_s_sleep(1);
        if ((++sp & 255u) == 0u) { if (xb_ld(&bar[XB_TMO])) break; if (sp > XB_SPIN_CAP) { atomicAdd(&bar[XB_TMO], 1u); break; } }
    }
    nloc = mine > 0u ? mine : 1u; nx = cnt > 0u ? cnt : 1u;
}
__device__ __forceinline__ void xcd_barrier(const XcdBarrier& b) {
    asm volatile("s_waitcnt vmcnt(0)" ::: "memory");
    __syncthreads();
    if (TIDX == 0) {
        unsigned* bar = b.bar;
        __builtin_amdgcn_s_waitcnt(0);
        unsigned nloc = b.st[0], nx = b.st[1];
        if (nloc == 0u) { xcd_barrier_complete(bar, b.x, nloc, nx); b.st[0] = nloc; b.st[1] = nx; }
        const unsigned old = xb_add(&bar[XB_XSUB(b.x)], 1u);
        const unsigned gen = old / nloc;
        if (old + 1u == (gen + 1u) * nloc) {
            __builtin_amdgcn_fence(__ATOMIC_RELEASE, "agent");
            asm volatile("s_waitcnt vmcnt(0)" ::: "memory");
            const unsigned og = xb_add(&bar[XB_TOP], 1u);
            const unsigned tg = og / nx;
            if (og + 1u == (tg + 1u) * nx) xb_add(&bar[XB_TOPGEN], 1u);
            else XB_SPIN(xb_ld(&bar[XB_TOPGEN]) == tg, bar);
            __builtin_amdgcn_fence(__ATOMIC_ACQUIRE, "agent");
            xb_add(&bar[XB_XGEN(b.x)], 1u);
            asm volatile("s_waitcnt vmcnt(0)" ::: "memory");
        } else {
            XB_SPIN(xb_ld(&bar[XB_XGEN(b.x)]) == gen, bar);
            __builtin_amdgcn_fence(__ATOMIC_ACQUIRE, "agent");
            asm volatile("s_waitcnt vmcnt(0)" ::: "memory");
        }
    }
    __syncthreads();
}
constexpr int LDS_BAR_OFF = LDS_TOP - 16;
#endif

constexpr int N_PHASES = 27;
#ifdef CPU_EMU
struct XcdBarrier { int dummy; };
#endif
template <int PH> DEVFN void run_phase(const Params& p, const XcdBarrier& bar) {
    unsigned char* ws = p.ws;
    bf16_t* XN = (bf16_t*)(ws + OFF_XN);
    if constexpr (PH == 0) ph_prologue(p);
#ifdef CPU_EMU
    else if constexpr (PH == 1) GEMM(XN, 1024, (const bf16_t*)(ws + W_HYIN), T_, HYIN_P, 1024, (EStoreF32{(float*)(ws + OFF_BIG), HYIN_P, HYIN_P}));
#else
    else if constexpr (PH == 1) gemm_gpu_epi(XN, 1024, (const bf16_t*)(ws + W_HYIN), T_, HYIN_P, 1024, (pg8::EpiStoreBf16Perm{(bf16_t*)(ws + OFF_BIG), HYIN_P}));
#endif
#ifdef CPU_EMU
    else if constexpr (PH == 2) ph_l0_a(p);
    else if constexpr (PH == 3) ph_l0_b(p);
    else if constexpr (PH == 4) ph_l0_scan(p);
    else if constexpr (PH == 5) ph_l0_fix(p);
#else
    else if constexpr (PH == 2) ph_l0_a_gpu(p);
    else if constexpr (PH == 3) {
#pragma unroll 1
        for (int hf = 0; hf < 2; ++hf)
            gemm_gpu_epi((const bf16_t*)(ws + OFF_XN) + 256 * hf, 512, (const bf16_t*)(ws + W_GATE) + (size_t)512 * hf * 512 + 256 * hf, T_, 512, 256,
                (pg8::EpiGates{(const bf16_t*)(ws + OFF_XN), (float*)(ws + OFF_BIG + (size_t)T_ * 4096), p.in[I_BA], p.in[I_BX], p.in[I_LAM], 512 * hf}), 128 * hf, 512);
    }
    else if constexpr (PH == 4) {
        gemm_gpu_epi((const bf16_t*)((unsigned char*)p.out + DO_QLAT), 384, (const bf16_t*)(ws + W_UQ), T_, 768, 384, (pg8::EpiStoreBf16Perm{(bf16_t*)(ws + OFF_XN), 768}));
        gemm_gpu_epi((const bf16_t*)((unsigned char*)p.out + DO_KVLAT), 256, (const bf16_t*)(ws + W_UKV), T_, 1024, 256, (pg8::EpiMlaKV{ws, (unsigned char*)p.out, p.in[I_QNK]}));
        ph_l0_scan1_gpu(p);
    }
    else if constexpr (PH == 5) { ph_l0_scan2_gpu(p); ph_l0_attn_mfma(p); }
#endif
    else if constexpr (PH == 6) {
#ifdef CPU_EMU
        GEMM((const bf16_t*)((unsigned char*)p.out + DO_QLAT), 384, (const bf16_t*)(ws + W_UQ), T_, 768, 384, (EStoreF32{(float*)(ws + OFF_BIG), 768, 768}));
        GEMM((const bf16_t*)((unsigned char*)p.out + DO_KVLAT), 256, (const bf16_t*)(ws + W_UKV), T_, 1024, 256, (EStoreF32{(float*)(ws + OFF_BIG) + (size_t)T_ * 768, 1024, 1024}));
#endif
    }
#ifdef CPU_EMU
    else if constexpr (PH == 7) ph_l0_hn(p);
#else
    else if constexpr (PH == 7) { }
#endif
    else if constexpr (PH == 8) {
#ifdef CPU_EMU
        ph_l0_attn(p);
#endif
    }
#ifdef CPU_EMU
    else if constexpr (PH == 9) GEMM((const bf16_t*)(ws + SM_CAT), 1024, (const bf16_t*)(ws + W_HYOUT), T_, 1024, 1024, (EResAddF32{p.in[I_X], p.out, 1024}));
    else if constexpr (PH == 10) ph_norm(p, p.in[I_NMLP]);
    else if constexpr (PH == 11) GEMM(XN, 1024, (const bf16_t*)(ws + W_MLP1), T_, 4096, 1024, (ERelu2Bf16{(bf16_t*)(ws + OFF_BIG), 4096}));
    else if constexpr (PH == 12) GEMM((const bf16_t*)(ws + OFF_BIG), 4096, (const bf16_t*)(ws + W_MLP2), T_, 1024, 4096, (EResAddF32{p.out, p.out, 1024}));
    else if constexpr (PH == 13) ph_norm(p, p.in[I_NMIX] + 1024);
    else if constexpr (PH == 14) GEMM(XN, 1024, (const bf16_t*)(ws + W_NSAIN), T_, NSAIN_P, 1024, (EStoreF32{(float*)(ws + OFF_BIG), NSAIN_P, NSAIN_P}));
    else if constexpr (PH == 15) ph_l1_prep(p);
#else
    else if constexpr (PH == 9) gemm_gpu_epi((const bf16_t*)(ws + SM_CAT), 1024, (const bf16_t*)(ws + W_HYOUT), T_, 1024, 1024, (pg8::EpiResNorm<true, false>{p.in[I_X], nullptr, nullptr, XN, (float*)(ws + OFF_SSQ)}));
    else if constexpr (PH == 11) gemm_gpu_epi(XN, 1024, (const bf16_t*)(ws + W_MLP1), T_, 4096, 1024, (pg8::EpiUpRelu2Perm{(bf16_t*)(ws + OFF_BIG), (const float*)(ws + OFF_SSQ)}));
    else if constexpr (PH == 12) gemm_gpu_epi((const bf16_t*)(ws + OFF_BIG), 4096, (const bf16_t*)(ws + W_MLP2), T_, 1024, 4096, (pg8::EpiResNorm<false, false>{nullptr, XN, nullptr, XN, (float*)(ws + OFF_SSQ)}));
    else if constexpr (PH == 14) {
        gemm_gpu_epi(XN, 1024, (const bf16_t*)(ws + W_NSAIN), T_, 1024, 1024,
            (pg8::EpiNsaIn<true>{(const float*)(ws + OFF_SSQ), p.in[I_NQN], p.in[I_NKN], (bf16_t*)(ws + OFF_QN), (bf16_t*)(ws + SM_KV), (float*)(ws + SM_GATE)}));
        gemm_gpu_epi(XN, 1024, (const bf16_t*)(ws + W_NSAIN) + (size_t)1024 * 1024, T_, 1024, 1024,
            (pg8::EpiNsaIn<false>{(const float*)(ws + OFF_SSQ), p.in[I_NQN], p.in[I_NKN], (bf16_t*)(ws + OFF_QN), (bf16_t*)(ws + SM_KV), (float*)(ws + SM_GATE)}));
    }
#endif
    else if constexpr (PH == 16) {
#ifdef CPU_EMU
        const float* cb = (const float*)(ws + OFF_CBIAS);
        GEMM((const bf16_t*)(ws + SM_KV), 1024, (const bf16_t*)(ws + W_C1K), MCMP, 256, 2048, (EGeluBiasBf16{(bf16_t*)(ws + SM_HK), 256, cb}));
        GEMM((const bf16_t*)(ws + SM_KV + KVSZ), 1024, (const bf16_t*)(ws + W_C1V), MCMP, 256, 2048, (EGeluBiasBf16{(bf16_t*)(ws + SM_HV), 256, cb + 256}));
#else
#pragma unroll 1
        for (int i = 0; i < 16; ++i) { const int kv = i >> 3, sl = i & 7;
            gemm_gpu((const bf16_t*)(ws + SM_KV + (size_t)kv * KVSZ) + sl * 256, 1024, (const bf16_t*)(ws + (kv ? W_C1V : W_C1K)) + sl * 256, MCMP, 256, 256,
                     (EStoreF32{(float*)(ws + OFF_BIG + (size_t)T_ * 2048) + (size_t)i * MCMP * 256, 256, 256}), 8 * i, 2048); }
        ph_l1_win_mfma(p);
#endif
    }
    else if constexpr (PH == 17) ph_l1_ck(p);
#ifdef CPU_EMU
    else if constexpr (PH == 18) ph_l1_cattn(p);
    else if constexpr (PH == 19) ph_l1_imp(p);
    else if constexpr (PH == 20) ph_l1_topk(p);
#else
    else if constexpr (PH == 18) {
        ph_l1_cmp_mfma(p);
        if (gridDim.x == 256) { asm volatile("s_waitcnt vmcnt(0)" ::: "memory"); __syncthreads(); }
        else xcd_barrier(bar);
        ph_l1_sel_ring(p);
    }
    else if constexpr (PH == 19) { }
    else if constexpr (PH == 20) { }
#endif
    else if constexpr (PH == 21) {
#ifdef CPU_EMU
        ph_l1_selwin<true>(p);
#endif
    }
#ifdef CPU_EMU
    else if constexpr (PH == 22) GEMM((const bf16_t*)(ws + OFF_BIG + (size_t)T_ * 4096), 1024, (const bf16_t*)(ws + W_NSAOUT), T_, 1024, 1024, (EResAddF32{p.out, p.out, 1024}));
    else if constexpr (PH == 23) ph_norm(p, p.in[I_NMLP] + 1024);
    else if constexpr (PH == 24) GEMM(XN, 1024, (const bf16_t*)(ws + W_MLP1) + (size_t)4096 * 1024, T_, 4096, 1024, (ERelu2Bf16{(bf16_t*)(ws + OFF_BIG), 4096}));
#else
    else if constexpr (PH == 22) gemm_gpu_epi((const bf16_t*)(ws + OFF_BIG + (size_t)T_ * 4096), 1024, (const bf16_t*)(ws + W_NSAOUT), T_, 1024, 1024, (pg8::EpiResNorm<false, false>{nullptr, XN, nullptr, XN, (float*)(ws + OFF_SSQ)}));
    else if constexpr (PH == 24) gemm_gpu_epi(XN, 1024, (const bf16_t*)(ws + W_MLP1) + (size_t)4096 * 1024, T_, 4096, 1024, (pg8::EpiUpRelu2Perm{(bf16_t*)(ws + OFF_BIG), (const float*)(ws + OFF_SSQ)}));
#endif
#ifdef CPU_EMU
    else if constexpr (PH == 25) GEMM((const bf16_t*)(ws + OFF_BIG), 4096, (const bf16_t*)(ws + W_MLP2) + (size_t)4096 * 1024, T_, 1024, 4096, (EResAddF32{p.out, p.out, 1024}));
#else
    else if constexpr (PH == 25) gemm_gpu_epi((const bf16_t*)(ws + OFF_BIG), 4096, (const bf16_t*)(ws + W_MLP2) + (size_t)4096 * 1024, T_, 1024, 4096, (pg8::EpiResNorm<false, true>{nullptr, XN, p.out, nullptr, nullptr}));
#endif
    else if constexpr (PH == 26) { }
}

#ifndef CPU_EMU
constexpr int NTHREADS = 512;
constexpr int LDS_BYTES = LDS_TOP;
namespace cg = cooperative_groups;

constexpr int NTHREADS_ = 512;
template <int PH> __device__ __forceinline__ void run_from(const Params& p, cg::grid_group& grid, const XcdBarrier& bar) {
    if constexpr (PH < N_PHASES - 1) {
        constexpr bool empty = (PH == 6 || PH == 7 || PH == 8 || PH == 10 || PH == 13 || PH == 15 || PH == 19 || PH == 20 || PH == 21 || PH == 23);
        if constexpr (!empty) {
            if constexpr (PH == 0) {
                if (blockIdx.x == 0 && TIDX < 31) ((const float**)(p.ws + OFF_PTRS))[TIDX] = p.in[TIDX];
                if (blockIdx.x == 0) for (int i = TIDX; i < XCD_BAR_WORDS; i += NTHREADS_) bar.bar[i] = 0u;
                run_phase<PH>(p, bar);
            } else {
                Params q; q.out = p.out; q.ws = p.ws;
                const float* const* tab = (const float* const*)(p.ws + OFF_PTRS);
#pragma unroll
                for (int i = 0; i < 31; ++i) q.in[i] = tab[i];
                run_phase<PH>(q, bar);
            }
            if constexpr (PH + 1 < N_PHASES - 1) { if constexpr (PH == 0) { grid.sync(); xcd_barrier_census(bar); } else xcd_barrier(bar); }
        }
        run_from<PH + 1>(p, grid, bar);
    }
}
__global__ void __launch_bounds__(NTHREADS, 2) mega_fwd(Params p) {
    cg::grid_group grid = cg::this_grid();
    volatile LAS unsigned* st = (volatile LAS unsigned*)((LAS unsigned char*)g_lds + LDS_BAR_OFF);
    {
        const unsigned hw = (unsigned)__builtin_amdgcn_s_getreg((5 << 11) | 4) & 63u;
        if ((threadIdx.x & 63u) == 0u) ((volatile LAS int*)((LAS unsigned char*)g_lds + LDS_SLOT_OFF))[hw] = (int)(threadIdx.x >> 6);
        if (threadIdx.x == 0) { st[0] = 0u; st[1] = 0u; }
    }
    __syncthreads();
    const XcdBarrier bar = xcd_barrier_post((unsigned*)(p.ws + OFF_CTL), st);
    run_from<0>(p, grid, bar);
}

extern "C" void kernel_launch(void* const* d_in, const int* in_sizes, int n_in, void* d_out, int out_size, void* d_ws, size_t ws_size, hipStream_t stream) {
    if (n_in != 31 || out_size != T_ * D_ || ws_size < WS_NEED) { fprintf(stderr, "kernel_launch: unexpected shapes (n_in %d out %d ws %zu need %zu)\n", n_in, out_size, ws_size, (size_t)WS_NEED); return; }
    static int grid_blocks = 0;
    if (!grid_blocks) {
        int dev = 0, cus = 0, per_cu = 0;
        (void)hipGetDevice(&dev);
        (void)hipDeviceGetAttribute(&cus, hipDeviceAttributeMultiprocessorCount, dev);
        (void)hipFuncSetAttribute((const void*)mega_fwd, hipFuncAttributeMaxDynamicSharedMemorySize, LDS_BYTES);
        (void)hipOccupancyMaxActiveBlocksPerMultiprocessor(&per_cu, (const void*)mega_fwd, NTHREADS, LDS_BYTES);
        if (per_cu < 1) { fprintf(stderr, "kernel_launch: occupancy query returned %d\n", per_cu); per_cu = 1; }
        if (per_cu > 1) per_cu = 1;
        grid_blocks = cus * per_cu;
    }
    Params p{};
    for (int i = 0; i < 31; ++i) p.in[i] = (const float*)d_in[i];
    p.out = (float*)d_out; p.ws = (unsigned char*)d_ws;
    void* args[] = {&p};
    hipError_t e = hipLaunchCooperativeKernel((const void*)mega_fwd, dim3(grid_blocks), dim3(NTHREADS), args, LDS_BYTES, stream);
    if (e != hipSuccess) fprintf(stderr, "cooperative launch failed: %s (grid %d)\n", hipGetErrorString(e), grid_blocks);
}
#endif
```
